# Optimizing an MI355X kernel written in HIP

```python
import math
import jax
import jax.numpy as jnp
from jax import lax
import numpy as np

D_MODEL = 1024
BATCH = 8
SEQ = 4096
DEPTH = 4

CTX_LEN = 256
GRID_W = 64
N_MIXERS = 3
N_MOD = 9
D_FF = 2816
NORM_EPS = 1e-6

S5_GROUP = 16
S5_GROUPS = D_MODEL // S5_GROUP
S5_STATE = 64
S5_BLOCK = 128
S5_DT_MIN = 1e-3
S5_DT_MAX = 1e-1

GLA_HEADS = 4
GLA_DK = D_MODEL // 2 // GLA_HEADS
GLA_DV = D_MODEL // GLA_HEADS
GLA_RANK = 16
GLA_TAU = 16.0

HGRN_DK = 128
HGRN_HEADS = D_MODEL // HGRN_DK
HGRN_DV = D_MODEL // HGRN_HEADS

LIN_CHUNK = 64

N_S5 = len(range(0, DEPTH, N_MIXERS))
N_GLA = len(range(1, DEPTH, N_MIXERS))
N_HGRN = len(range(2, DEPTH, N_MIXERS))

F32 = jnp.float32

kernel_name = 'hybrid_s5_gla_hgrn2_prefix_trunk'


def rmsnorm(x, w):
    xf = x.astype(F32)
    y = xf * lax.rsqrt(jnp.mean(xf * xf, axis=-1, keepdims=True) + NORM_EPS)
    return (y * w.astype(F32)).astype(x.dtype)


def swiglu_ffn(h, w_in, w_out):
    gu = jnp.einsum('bld,df->blf', h, w_in)
    g, u = jnp.split(gu, 2, axis=-1)
    return jnp.einsum('blf,fd->bld', jax.nn.silu(g) * u, w_out)


def ffn_half_step(x, w_norm, shift, scale, gate, w_in, w_out):
    h = rmsnorm(x, w_norm) * (1.0 + scale) + shift
    return x + 0.5 * gate * swiglu_ffn(h, w_in, w_out)


def grid_to_col_major(t, rows):
    b, l, e = t.shape
    return t.reshape(b, rows, GRID_W, e).transpose(0, 2, 1, 3).reshape(b, l, e)


def col_major_to_grid(t, rows):
    b, l, e = t.shape
    return t.reshape(b, GRID_W, rows, e).transpose(0, 2, 1, 3).reshape(b, l, e)


def s5_discretize(a_re, a_im, log_step, b_re, b_im):
    dt = jnp.exp(log_step.astype(F32))[..., None]
    a_re = a_re.astype(F32)
    a_im = a_im.astype(F32)
    mag = jnp.exp(a_re * dt)
    abar_re = mag * jnp.cos(a_im * dt)
    abar_im = mag * jnp.sin(a_im * dt)
    den = a_re * a_re + a_im * a_im
    zr = abar_re - 1.0
    zi = abar_im
    coef_re = ((zr * a_re + zi * a_im) / den)[..., None]
    coef_im = ((zi * a_re - zr * a_im) / den)[..., None]
    b_re = b_re.astype(F32)
    b_im = b_im.astype(F32)
    bbar_re = coef_re * b_re - coef_im * b_im
    bbar_im = coef_re * b_im + coef_im * b_re
    return abar_re, abar_im, bbar_re, bbar_im


def s5_combine(e1, e2):
    ar1, ai1, br1, bi1 = e1
    ar2, ai2, br2, bi2 = e2
    return (ar1 * ar2 - ai1 * ai2, ar1 * ai2 + ai1 * ar2,
            ar2 * br1 - ai2 * bi1 + br2, ar2 * bi1 + ai2 * br1 + bi2)


def s5_direction(u, abar_re, abar_im, bbar_re, bbar_im, c_re, c_im, h0_re, h0_im):
    bsz, length = u.shape[0], u.shape[1]
    n_blk = length // S5_BLOCK
    ub = jnp.swapaxes(u.reshape(bsz, n_blk, S5_BLOCK, S5_GROUPS, S5_GROUP), 0, 1)
    a_re = jnp.broadcast_to(abar_re, (bsz, S5_BLOCK, S5_GROUPS, S5_STATE))
    a_im = jnp.broadcast_to(abar_im, (bsz, S5_BLOCK, S5_GROUPS, S5_STATE))

    def step(carry, ublk):
        h_re, h_im = carry
        bu_re = jnp.einsum('blgc,gpc->blgp', ublk, bbar_re)
        bu_im = jnp.einsum('blgc,gpc->blgp', ublk, bbar_im)
        ca_re, ca_im, cb_re, cb_im = lax.associative_scan(s5_combine, (a_re, a_im, bu_re, bu_im), axis=1)
        hs_re = ca_re * h_re[:, None] - ca_im * h_im[:, None] + cb_re
        hs_im = ca_re * h_im[:, None] + ca_im * h_re[:, None] + cb_im
        y = jnp.einsum('blgp,gcp->blgc', hs_re, c_re) - jnp.einsum('blgp,gcp->blgc', hs_im, c_im)
        return (hs_re[:, -1], hs_im[:, -1]), y

    (h_re, h_im), y = lax.scan(step, (h0_re, h0_im), ub)
    y = jnp.swapaxes(y, 0, 1).reshape(bsz, length, S5_GROUPS, S5_GROUP)
    return y, h_re, h_im


def s5_mixer(hc, hx, a_re, a_im, log_step, b_re, b_im, c_re, c_im, d_skip, w_glu, b_glu, need_ctx):
    abar_re, abar_im, bbar_re, bbar_im = s5_discretize(a_re, a_im, log_step, b_re, b_im)
    c_re = c_re.astype(F32)
    c_im = c_im.astype(F32)

    def groups(h):
        return h.astype(F32).reshape(h.shape[0], h.shape[1], S5_GROUPS, S5_GROUP)

    uc, ux = groups(hc), groups(hx)
    h0 = jnp.zeros((hc.shape[0], S5_GROUPS, S5_STATE), F32)
    fwd = (abar_re[0], abar_im[0], bbar_re[0], bbar_im[0], c_re[0], c_im[0])
    bwd = (abar_re[1], abar_im[1], bbar_re[1], bbar_im[1], c_re[1], c_im[1])
    yc_f, hf_re, hf_im = s5_direction(uc, *fwd, h0, h0)
    yc_b, hb_re, hb_im = s5_direction(jnp.flip(uc, 1), *bwd, h0, h0)
    yx_f, _, _ = s5_direction(ux, *fwd, hf_re, hf_im)
    yx_b, _, _ = s5_direction(jnp.flip(ux, 1), *bwd, hb_re, hb_im)

    def readout(h, y_f, y_b_rev):
        bsz, length, _ = h.shape
        y = (y_f + jnp.flip(y_b_rev, 1)).reshape(bsz, length, D_MODEL) + d_skip.astype(F32) * h.astype(F32)
        z = jnp.einsum('bld,de->ble', jax.nn.gelu(y), w_glu.astype(F32)) + b_glu.astype(F32)
        val, gate = jnp.split(z, 2, axis=-1)
        return (val * jax.nn.sigmoid(gate)).astype(h.dtype)

    yx = readout(hx, yx_f, yx_b)
    yc = readout(hc, yc_f, yc_b) if need_ctx else None
    return yc, yx


def chunk_gated_scan(q, k, v, log_g, s0):
    bsz, length, n_heads, _ = q.shape
    dv = v.shape[-1]
    n_chunks = length // LIN_CHUNK

    def blocks(t):
        return jnp.moveaxis(t.reshape(bsz, n_chunks, LIN_CHUNK, *t.shape[2:]), 1, 0)

    lower = jnp.tril(jnp.ones((LIN_CHUNK, LIN_CHUNK), dtype=bool))[None, :, :, None, None]

    def step(state, blk):
        qb, kb, vb, gb = blk
        cum = jnp.cumsum(gb, axis=1)
        rel = jnp.exp(jnp.where(lower, cum[:, :, None] - cum[:, None, :], -jnp.inf))
        scores = jnp.einsum('bihk,bjhk,bijhk->bhij', qb, kb, rel)
        out = (jnp.einsum('bhij,bjhv->bihv', scores, vb)
               + jnp.einsum('bihk,bhkv->bihv', qb * jnp.exp(cum), state))
        last = cum[:, -1]
        k_dec = kb * jnp.exp(last[:, None] - cum)
        state = jnp.exp(last)[..., None] * state + jnp.einsum('bjhk,bjhv->bhkv', k_dec, vb)
        return state, out

    s_final, out = lax.scan(step, s0, (blocks(q), blocks(k), blocks(v), blocks(log_g)))
    out = jnp.moveaxis(out, 0, 1).reshape(bsz, length, n_heads, dv)
    return out, s_final


def bidir_gated(ctx_in, lat_in, need_ctx):
    qc, kfc, kbc, vc, gfc, gbc = ctx_in
    qx, kfx, kbx, vx, gfx, gbx = lat_in

    def flip(t):
        return jnp.flip(t, axis=1)

    s0 = jnp.zeros((qc.shape[0], qc.shape[2], qc.shape[3], vc.shape[3]), F32)
    oc_f, s_f = chunk_gated_scan(qc, kfc, vc, gfc, s0)
    oc_b, s_b = chunk_gated_scan(flip(qc), flip(kbc), flip(vc), flip(gbc), s0)
    ox_f, _ = chunk_gated_scan(qx, kfx, vx, gfx, s_f)
    ox_b, _ = chunk_gated_scan(flip(qx), flip(kbx), flip(vx), flip(gbx), s_b)
    ox = ox_f + flip(ox_b)
    oc = oc_f + flip(oc_b) if need_ctx else None
    return oc, ox


def gated_head_out(o, gate, norm_w, w_out, dtype):
    bsz, length = o.shape[0], o.shape[1]
    o = rmsnorm(o, norm_w).reshape(bsz, length, -1) * jax.nn.silu(gate)
    return jnp.einsum('ble,ed->bld', o, w_out.astype(F32)).astype(dtype)


def gla_mixer(hc, hx, rows, w_in, w_gate, b_gate, norm_w, w_out, need_ctx):
    dkt, dvt = GLA_HEADS * GLA_DK, GLA_HEADS * GLA_DV

    def project(h):
        bsz, length, _ = h.shape
        p = jnp.einsum('bld,de->ble', h, w_in).astype(F32)
        q, k, v, r, low = jnp.split(p, [dkt, 2 * dkt, 2 * dkt + dvt, 2 * dkt + 2 * dvt], axis=-1)
        low = low.reshape(bsz, length, 2, GLA_RANK)
        log_a = jax.nn.log_sigmoid(jnp.einsum('blzr,zrk->blzk', low, w_gate.astype(F32)) + b_gate.astype(F32)) / GLA_TAU
        q = q.reshape(bsz, length, GLA_HEADS, GLA_DK) * (GLA_DK ** -0.5)
        k = k.reshape(bsz, length, GLA_HEADS, GLA_DK)
        v = v.reshape(bsz, length, GLA_HEADS, GLA_DV)
        g_f = log_a[:, :, 0].reshape(bsz, length, GLA_HEADS, GLA_DK)
        g_b = log_a[:, :, 1].reshape(bsz, length, GLA_HEADS, GLA_DK)
        return (q, k, k, v, g_f, g_b), r

    ctx_in, r_c = project(hc)
    lat_in, r_x = project(grid_to_col_major(hx, rows))
    oc, ox = bidir_gated(ctx_in, lat_in, need_ctx)
    yx = col_major_to_grid(gated_head_out(ox, r_x, norm_w, w_out, hx.dtype), rows)
    yc = gated_head_out(oc, r_c, norm_w, w_out, hc.dtype) if need_ctx else None
    return yc, yx


def hgrn_mixer(hc, hx, w_in, lower_bound, norm_w, w_out, need_ctx):
    lb = lower_bound.astype(F32).reshape(2, HGRN_HEADS, HGRN_DK)

    def project(h):
        bsz, length, _ = h.shape
        p = jnp.einsum('bld,de->ble', h, w_in).astype(F32)
        q, i, z_f, z_b, g = jnp.split(p, 5, axis=-1)

        def heads(t):
            return t.reshape(bsz, length, HGRN_HEADS, HGRN_DK)

        z_f, z_b = heads(z_f), heads(z_b)
        log_f_f = jnp.log(lb[0] + (1.0 - lb[0]) * jax.nn.sigmoid(z_f))
        log_f_b = jnp.log(lb[1] + (1.0 - lb[1]) * jax.nn.sigmoid(z_b))
        k_f = (1.0 - lb[0]) * jax.nn.sigmoid(-z_f)
        k_b = (1.0 - lb[1]) * jax.nn.sigmoid(-z_b)
        v = i.reshape(bsz, length, HGRN_HEADS, HGRN_DV)
        return (heads(jax.nn.silu(q)), k_f, k_b, v, log_f_f, log_f_b), g

    ctx_in, g_c = project(hc)
    lat_in, g_x = project(hx)
    oc, ox = bidir_gated(ctx_in, lat_in, need_ctx)
    yx = gated_head_out(ox, g_x, norm_w, w_out, hx.dtype)
    yc = gated_head_out(oc, g_c, norm_w, w_out, hc.dtype) if need_ctx else None
    return yc, yx


def setup_inputs(seed: int = 0) -> dict:
    key = jax.random.key(seed)
    ks = iter(jax.random.split(key, 32))

    def normal(shape, scale):
        return jax.random.normal(next(ks), shape, jnp.float32) * scale

    d = D_MODEL
    dkt, dvt = GLA_HEADS * GLA_DK, GLA_HEADS * GLA_DV
    n_idx = jnp.arange(S5_STATE, dtype=jnp.float32)
    s5_a = (N_S5, 2, S5_GROUPS, S5_STATE)
    s5_b = (N_S5, 2, S5_GROUPS, S5_STATE, S5_GROUP)
    s5_c = (N_S5, 2, S5_GROUPS, S5_GROUP, S5_STATE)
    return {
        'x': normal((BATCH, SEQ, d), 1.0),
        'c': normal((BATCH, d), 1.0),
        'ctx': normal((BATCH, CTX_LEN, d), 1.0),
        'c_ctx': normal((d,), 1.0),
        'ada_w': normal((DEPTH, d, N_MOD * d), 0.5 * d ** -0.5),
        'ada_b': normal((DEPTH, N_MOD * d), 0.02),
        'norm_w': 1.0 + normal((DEPTH, 3, d), 0.02),
        'ffn_w_in': normal((DEPTH, 2, d, 2 * D_FF), d ** -0.5),
        'ffn_w_out': normal((DEPTH, 2, D_FF, d), D_FF ** -0.5),
        's5_a_re': -0.5 + normal(s5_a, 0.01),
        's5_a_im': math.pi * n_idx + normal(s5_a, 0.01),
        's5_log_step': jax.random.uniform(next(ks), (N_S5, 2, S5_GROUPS), jnp.float32,
                                          math.log(S5_DT_MIN), math.log(S5_DT_MAX)),
        's5_b_re': normal(s5_b, (2 * S5_GROUP) ** -0.5),
        's5_b_im': normal(s5_b, (2 * S5_GROUP) ** -0.5),
        's5_c_re': normal(s5_c, S5_STATE ** -0.5),
        's5_c_im': normal(s5_c, S5_STATE ** -0.5),
        's5_d': normal((N_S5, d), 0.5),
        's5_w_glu': normal((N_S5, d, 2 * d), d ** -0.5),
        's5_b_glu': normal((N_S5, 2 * d), 0.02),
        'gla_w_in': normal((N_GLA, d, 2 * dkt + 2 * dvt + 2 * GLA_RANK), d ** -0.5),
        'gla_w_gate': normal((N_GLA, 2, GLA_RANK, dkt), GLA_RANK ** -0.5),
        'gla_b_gate': normal((N_GLA, 2, dkt), 0.02),
        'gla_norm_w': 1.0 + normal((N_GLA, GLA_DV), 0.02),
        'gla_w_out': normal((N_GLA, dvt, d), dvt ** -0.5),
        'hgrn_w_in': normal((N_HGRN, d, 5 * d), d ** -0.5),
        'hgrn_lb_logits': normal((DEPTH, 2, d), 0.1),
        'hgrn_norm_w': 1.0 + normal((N_HGRN, HGRN_DV), 0.02),
        'hgrn_w_out': normal((N_HGRN, d, d), d ** -0.5),
        'final_norm_w': 1.0 + normal((d,), 0.02),
    }


def reference(x, c, ctx, c_ctx, ada_w, ada_b, norm_w, ffn_w_in, ffn_w_out,
              s5_a_re, s5_a_im, s5_log_step, s5_b_re, s5_b_im, s5_c_re, s5_c_im, s5_d,
              s5_w_glu, s5_b_glu, gla_w_in, gla_w_gate, gla_b_gate, gla_norm_w, gla_w_out,
              hgrn_w_in, hgrn_lb_logits, hgrn_norm_w, hgrn_w_out, final_norm_w):
    rows = x.shape[1] // GRID_W
    lb_soft = jax.nn.softmax(hgrn_lb_logits.astype(F32), axis=0)
    lb_all = jnp.cumsum(lb_soft, axis=0) - lb_soft[0]
    xc = ctx
    for i in range(DEPTH):
        last = i == DEPTH - 1
        mod_x = (jnp.einsum('bd,de->be', jax.nn.silu(c), ada_w[i]) + ada_b[i])[:, None, :]
        mod_c = (jnp.einsum('d,de->e', jax.nn.silu(c_ctx), ada_w[i]) + ada_b[i])[None, None, :]
        sx = jnp.split(mod_x, N_MOD, axis=-1)
        sc = jnp.split(mod_c, N_MOD, axis=-1)

        x = ffn_half_step(x, norm_w[i, 0], sx[0], sx[1], sx[2], ffn_w_in[i, 0], ffn_w_out[i, 0])
        xc = ffn_half_step(xc, norm_w[i, 0], sc[0], sc[1], sc[2], ffn_w_in[i, 0], ffn_w_out[i, 0])

        hx = rmsnorm(x, norm_w[i, 1]) * (1.0 + sx[4]) + sx[3]
        hc = rmsnorm(xc, norm_w[i, 1]) * (1.0 + sc[4]) + sc[3]
        kind, j = i % N_MIXERS, i // N_MIXERS
        if kind == 0:
            yc, yx = s5_mixer(hc, hx, s5_a_re[j], s5_a_im[j], s5_log_step[j], s5_b_re[j], s5_b_im[j],
                              s5_c_re[j], s5_c_im[j], s5_d[j], s5_w_glu[j], s5_b_glu[j], not last)
        elif kind == 1:
            yc, yx = gla_mixer(hc, hx, rows, gla_w_in[j], gla_w_gate[j], gla_b_gate[j],
                               gla_norm_w[j], gla_w_out[j], not last)
        else:
            yc, yx = hgrn_mixer(hc, hx, hgrn_w_in[j], lb_all[i], hgrn_norm_w[j], hgrn_w_out[j], not last)
        x = x + sx[5] * yx

        x = ffn_half_step(x, norm_w[i, 2], sx[6], sx[7], sx[8], ffn_w_in[i, 1], ffn_w_out[i, 1])
        if not last:
            xc = xc + sc[5] * yc
            xc = ffn_half_step(xc, norm_w[i, 2], sc[6], sc[7], sc[8], ffn_w_in[i, 1], ffn_w_out[i, 1])
    return rmsnorm(x, final_norm_w)
```

```cpp
#include <hip/hip_runtime.h>
#include <hip/hip_cooperative_groups.h>
#include <cstdio>
namespace cg = cooperative_groups;

#ifndef COOP
#define COOP 1
#endif

#define LAS __attribute__((address_space(3)))
typedef unsigned short bf16_t;
typedef short bf16x8 __attribute__((ext_vector_type(8)));
typedef float f32x4 __attribute__((ext_vector_type(4)));
typedef float f32x16 __attribute__((ext_vector_type(16)));
typedef unsigned u32x4 __attribute__((ext_vector_type(4)));
typedef unsigned u32x2 __attribute__((ext_vector_type(2)));

constexpr int D = 1024, NB = 8, SEQ = 4096, CTXL = 256, ML = NB * SEQ, MC = NB * CTXL, MT = ML + MC, DFF = 2816, DEPTH = 4;
constexpr int NTHR = 512;
constexpr int LDS_MAIN = 157696;
constexpr int LDS_BYTES = LDS_MAIN + 16;

constexpr size_t WS_XC    = 0;
constexpr size_t WS_MOD   = WS_XC + (size_t)MC * D * 4;
constexpr size_t WS_LB    = WS_MOD + (size_t)4 * 9 * 9216 * 4;
constexpr size_t WS_WFI   = WS_LB + 8192;
constexpr size_t WS_WFO   = WS_WFI + (size_t)2 * 5632 * 1024 * 2;
constexpr size_t WS_WGLU  = WS_WFO + (size_t)2 * 1024 * 2816 * 2;
constexpr size_t WS_WGI   = WS_WGLU + (size_t)2 * 2048 * 1024 * 2;
constexpr size_t WS_WGO   = WS_WGI + (size_t)3328 * 1024 * 2;
constexpr size_t WS_WHI   = WS_WGO + (size_t)1024 * 1024 * 2;
constexpr size_t WS_WHO   = WS_WHI + (size_t)5120 * 1024 * 2;
constexpr size_t WS_H     = WS_WHO + (size_t)1024 * 1024 * 2;
constexpr size_t WS_BIG   = WS_H + (size_t)MT * D * 2;
constexpr size_t WS_OACC  = WS_BIG + (size_t)MT * 5120 * 2;
constexpr size_t WS_BAR   = WS_OACC + (size_t)MT * D * 4;
constexpr size_t WS_CNT   = WS_BAR + 16384;
constexpr size_t WS_ZERO_BYTES = 16384 + (size_t)12 * 128 * 256;
constexpr size_t WS_SLOT  = WS_BAR + WS_ZERO_BYTES;
constexpr size_t WS_X16   = WS_SLOT + (size_t)12 * ML * 4 * 4;
constexpr size_t WS_END   = WS_X16 + (size_t)MT * D * 2;

typedef __bf16 bf16v2_t __attribute__((ext_vector_type(2)));
typedef float f32v2_t __attribute__((ext_vector_type(2)));
__device__ __forceinline__ unsigned cvt_pk_bf16(float lo, float hi) { f32v2_t v = {lo, hi}; bf16v2_t b = __builtin_convertvector(v, bf16v2_t); return __builtin_bit_cast(unsigned, b); }
__device__ __forceinline__ bf16_t f2bf(float f) { return __builtin_bit_cast(unsigned short, (__bf16)f); }
__device__ __forceinline__ float bf2f(bf16_t b) { return __uint_as_float(((unsigned)b) << 16); }
typedef _Float16 f16v2_t __attribute__((ext_vector_type(2)));
__device__ __forceinline__ unsigned pack_h2(float a, float b) { f16v2_t h = {(_Float16)a, (_Float16)b}; return __builtin_bit_cast(unsigned, h); }
__device__ __forceinline__ float h2lo(unsigned w) { return (float)__builtin_bit_cast(f16v2_t, w).x; }
__device__ __forceinline__ float h2hi(unsigned w) { return (float)__builtin_bit_cast(f16v2_t, w).y; }
__device__ __forceinline__ f32x4 ld_h4(const void* p) { const u32x2 w = *(const u32x2*)p; return (f32x4){h2lo(w.x), h2hi(w.x), h2lo(w.y), h2hi(w.y)}; }
__device__ __forceinline__ void st_h4(void* p, f32x4 v) { u32x2 w; w.x = pack_h2(v[0], v[1]); w.y = pack_h2(v[2], v[3]); *(u32x2*)p = w; }
__device__ __forceinline__ void ld_h8(const void* p, f32x4& lo, f32x4& hi) { const u32x4 w = *(const u32x4*)p; lo = (f32x4){h2lo(w.x), h2hi(w.x), h2lo(w.y), h2hi(w.y)}; hi = (f32x4){h2lo(w.z), h2hi(w.z), h2lo(w.w), h2hi(w.w)}; }
__device__ __forceinline__ void st_h8(void* p, f32x4 lo, f32x4 hi) { u32x4 w; w.x = pack_h2(lo[0], lo[1]); w.y = pack_h2(lo[2], lo[3]); w.z = pack_h2(hi[0], hi[1]); w.w = pack_h2(hi[2], hi[3]); *(u32x4*)p = w; }
__device__ __forceinline__ float bflo(unsigned w) { return __uint_as_float(w << 16); }
__device__ __forceinline__ float bfhi(unsigned w) { return __uint_as_float(w & 0xffff0000u); }
__device__ __forceinline__ float fsigmoid(float x) { return __builtin_amdgcn_rcpf(1.0f + __expf(-x)); }
__device__ __forceinline__ float fsilu(float x) { return x * fsigmoid(x); }
__device__ __forceinline__ float shfl_xor_l(float v, int mask, int lane) { return __int_as_float(__builtin_amdgcn_ds_bpermute((lane ^ mask) << 2, __float_as_int(v))); }
__device__ __forceinline__ int permrow(int row) { return (row & ~4095) | ((row & 63) << 6) | ((row >> 6) & 63); }

struct Params {
    const float* in[29];
    float* out;
    unsigned char* ws;
    int ph_lo, ph_hi;
};


#define XB_TMO      128
#define XB_XCNT(j)  (256  + 64 * (j))
#define XB_XSUB(j)  (1280 + 64 * (j))
#define XB_XGEN(j)  (2304 + 64 * (j))
#define XB_TOP      3328
#define XB_TOPGEN   3392
#define XCD_BAR_WORDS 3456
#define XB_SPIN_CAP (1u << 18)

__device__ __forceinline__ unsigned xb_ld(unsigned* p)              { return __hip_atomic_load(p, __ATOMIC_RELAXED, __HIP_MEMORY_SCOPE_AGENT); }
__device__ __forceinline__ unsigned xb_add(unsigned* p, unsigned v) { return __hip_atomic_fetch_add(p, v, __ATOMIC_RELAXED, __HIP_MEMORY_SCOPE_AGENT); }
__device__ __forceinline__ unsigned xb_xcc_id() { return (unsigned)__builtin_amdgcn_s_getreg((3 << 11) | 20) & 0xFu; }
#define XB_SPIN(cond, bar) do { unsigned _sp = 0; while (cond) { __builtin_amdgcn_s_sleep(1); \
    if ((++_sp & 255u) == 0u) { if (xb_ld(&(bar)[XB_TMO])) break; if (_sp > XB_SPIN_CAP) { atomicAdd(&(bar)[XB_TMO], 1u); break; } } } } while (0)

struct XcdBarrier {
    unsigned* bar; unsigned x;
    volatile LAS unsigned* st;
};

__device__ __forceinline__ XcdBarrier xcd_barrier_post(unsigned* bar, volatile LAS unsigned* st) {
    XcdBarrier b; b.bar = bar; b.x = xb_xcc_id(); b.st = st;
    if (threadIdx.x == 0) (void)xb_add(&bar[XB_XCNT(b.x)], 1u);
    return b;
}
__device__ __forceinline__ void xcd_barrier_complete(unsigned* bar, unsigned x, unsigned& nloc, unsigned& nx) {
    const unsigned G = gridDim.x * gridDim.y * gridDim.z;
    unsigned sum, cnt, mine, sp = 0u;
    for (;;) {
        sum = 0u; cnt = 0u; mine = 0u;
#pragma unroll
        for (unsigned j = 0; j < 16; ++j) { const unsigned c = xb_ld(&bar[XB_XCNT(j)]); sum += c; cnt += (c > 0u) ? 1u : 0u; mine = (j == x) ? c : mine; }
        if (sum == G) break;
        __builtin_amdgcn_s_sleep(1);
        if ((++sp & 255u) == 0u) { if (xb_ld(&bar[XB_TMO])) break; if (sp > XB_SPIN_CAP) { atomicAdd(&bar[XB_TMO], 1u); break; } }
    }
    nloc = mine > 0u ? mine : 1u; nx = cnt > 0u ? cnt : 1u;
}

__device__ __forceinline__ void xcd_barrier(const XcdBarrier& b) {
    asm volatile("s_waitcnt vmcnt(0)" ::: "memory");
    __syncthreads();
    if (threadIdx.x == 0) {
        unsigned* bar = b.bar;
        __builtin_amdgcn_s_waitcnt(0);
        unsigned nloc = b.st[0], nx = b.st[1];
        if (nloc == 0u) { xcd_barrier_complete(bar, b.x, nloc, nx); b.st[0] = nloc; b.st[1] = nx; }
        const unsigned old = xb_add(&bar[XB_XSUB(b.x)], 1u);
        const unsigned gen = old / nloc;
        if (old + 1u == (gen + 1u) * nloc) {
            __builtin_amdgcn_fence(__ATOMIC_RELEASE, "agent");
            asm volatile("s_waitcnt vmcnt(0)" ::: "memory");
            const unsigned og = xb_add(&bar[XB_TOP], 1u);
            const unsigned tg = og / nx;
            if (og + 1u == (tg + 1u) * nx) xb_add(&bar[XB_TOPGEN], 1u);
            else XB_SPIN(xb_ld(&bar[XB_TOPGEN]) == tg, bar);
            __builtin_amdgcn_fence(__ATOMIC_ACQUIRE, "agent");
            xb_add(&bar[XB_XGEN(b.x)], 1u);
            asm volatile("s_waitcnt vmcnt(0)" ::: "memory");
        } else {
            XB_SPIN(xb_ld(&bar[XB_XGEN(b.x)]) == gen, bar);
            __builtin_amdgcn_fence(__ATOMIC_ACQUIRE, "agent");
            asm volatile("s_waitcnt vmcnt(0)" ::: "memory");
        }
    }
    __syncthreads();
}
namespace pg8 {
#define PG8_LAS __attribute__((address_space(3)))
typedef unsigned short bf16_t;
typedef short bf16x8 __attribute__((ext_vector_type(8)));
typedef float f32x4 __attribute__((ext_vector_type(4)));
typedef unsigned u32x4 __attribute__((ext_vector_type(4)));
constexpr int BM = 256, BK = 64, HALF = 128, HTB = HALF * BK * 2  , STAGE_BYTES = 8 * HTB, NXCD = 8, WGM = 8;

__host__ __device__ __forceinline__ int lds_byte(int r, int c) { const int st = (r >> 4) * 2 + (c >> 5), rr = r & 15, cc = c & 31, ob = rr * 64 + cc * 2; return st * 1024 + (ob ^ (((ob >> 9) & 1) << 5)); }
__host__ __device__ __forceinline__ void stage_rc(int b, int& R, int& C) { const int st = b / 1024, sb = b % 1024, swz = sb ^ (((sb >> 9) & 1) << 5); R = (st >> 1) * 16 + swz / 64; C = (st & 1) * 32 + (swz % 64) / 2; }
__host__ __device__ __forceinline__ int perm32(int rho) { const int n = rho >> 4, i = rho & 15; return 8 * (i >> 2) + 4 * n + (i & 3); }

struct Unit { int pm, pn, k0, nt, sp; };
struct Gemm { const bf16_t* A; const bf16_t* Bt; int M, N, K; };

struct StaticOrder {
    int nM, nN, nwg, G, c, ntk;
    __host__ __device__ void init(int M, int N, int G_, int c_, int ntk_) { nM = M / BM; nN = N / BM; nwg = nM * nN; G = G_; c = c_; ntk = ntk_; }
    __host__ __device__ bool next(int i, Unit& u) const {
        const long L = (long)i * G + c; if (L >= nwg) return false;
        int wgid = (int)L; { const int q = nwg / NXCD, r = nwg % NXCD, xcd = wgid % NXCD, off = wgid / NXCD; wgid = (xcd < r ? xcd * (q + 1) : r * (q + 1) + (xcd - r) * q) + off; }
        const int nig = WGM * nN, gid = wgid / nig, fm = gid * WGM, gsz = (nM - fm) < WGM ? (nM - fm) : WGM;
        u.pm = fm + ((wgid % nig) % gsz); u.pn = (wgid % nig) / gsz; u.k0 = 0; u.nt = ntk; u.sp = -1; return true;
    }
    __device__ __forceinline__ void a_ready(const Unit&) const {}
    __device__ __forceinline__ void done(const Unit&) const {}
};

struct SplitOrder {
    StaticOrder lat, all; int nsplit, skip_ctx, ntk, G, c;
    __host__ __device__ void init(int Mlat, int Mall, int N, int G_, int c_, int ntk_, int nsplit_, int skip_) { lat.init(Mlat, N, G_, c_, ntk_); all.init(Mall, N, G_, c_, ntk_); nsplit = nsplit_; skip_ctx = skip_; ntk = ntk_; G = G_; c = c_; }
    __host__ __device__ bool next(int i, Unit& u) const {
        if (G != 256 || lat.nN != 4) return all.next(i, u);
        if (i < 2) return lat.next(i, u);
        if (i > 2 || skip_ctx || c >= 32 * nsplit) return false;
        const int cu = c / nsplit, s = c % nsplit, bs = (ntk / nsplit) & ~1;
        u.pm = lat.nM + (cu >> 2); u.pn = cu & 3; u.k0 = s * bs; u.nt = (s == nsplit - 1) ? ntk - s * bs : bs; u.sp = s; return true;
    }
    __device__ __forceinline__ void a_ready(const Unit&) const {}
    __device__ __forceinline__ void done(const Unit&) const {}
};

struct EpiSwiGLU {
    static constexpr bool PERM = true, AFTER_DRAIN = false;
    bf16_t* O; int ldc;
    __device__ __forceinline__ void operator()(const f32x4 (&acc)[2][2][4][2], const Unit& u, int wr, int wc, int fr, int fq) const {
        const int row0 = u.pm * BM + wr * 64 + fr, col0 = u.pn * 128 + wc * 32 + 8 * fq;
#pragma unroll
        for (int ai = 0; ai < 2; ++ai)
#pragma unroll
            for (int m = 0; m < 4; ++m) {
                bf16_t* rowp = O + (size_t)(row0 + ai * HALF + m * 16) * ldc + col0;
                float v[8];
#pragma unroll
                for (int n = 0; n < 2; ++n)
#pragma unroll
                    for (int i = 0; i < 4; ++i) { const float g = acc[ai][0][m][n][i], uu = acc[ai][1][m][n][i]; v[n * 4 + i] = ::fsilu(g) * uu; }
                u32x4 w; w.x = ::cvt_pk_bf16(v[0], v[1]); w.y = ::cvt_pk_bf16(v[2], v[3]); w.z = ::cvt_pk_bf16(v[4], v[5]); w.w = ::cvt_pk_bf16(v[6], v[7]);
                *(u32x4*)rowp = w;
            }
    }
};
struct EpiPlain {
    static constexpr bool PERM = true, AFTER_DRAIN = false;
    bf16_t* O; int ldc; int mode; const float* lb;
    __device__ __forceinline__ void operator()(const f32x4 (&acc)[2][2][4][2], const Unit& u, int wr, int wc, int fr, int fq) const {
        const int row0 = u.pm * BM + wr * 64 + fr, col0 = u.pn * BM + wc * 32 + 8 * fq;
        const int tr = (mode == 1) ? ((u.pn < 4) ? 1 : ((u.pn >= 8 && u.pn < 16) ? 2 : 0)) : 0;
        f32x4 lbv[2][2];
        if (tr == 2) {
#pragma unroll
            for (int bj = 0; bj < 2; ++bj)
#pragma unroll
                for (int n = 0; n < 2; ++n) lbv[bj][n] = *(const f32x4*)(lb + (col0 - 2048) + bj * HALF + 4 * n);
        }
#pragma unroll
        for (int ai = 0; ai < 2; ++ai)
#pragma unroll
            for (int m = 0; m < 4; ++m) {
                bf16_t* rowp = O + (size_t)(row0 + ai * HALF + m * 16) * ldc + col0;
#pragma unroll
                for (int bj = 0; bj < 2; ++bj) {
                    f32x4 v0 = acc[ai][bj][m][0], v1 = acc[ai][bj][m][1];
                    u32x4 w;
                    if (tr == 2) {
#pragma unroll
                        for (int i = 0; i < 4; ++i) {
                            const float s0 = ::fsigmoid(fminf(fmaxf(v0[i], -30.f), 30.f)), s1 = ::fsigmoid(fminf(fmaxf(v1[i], -30.f), 30.f));
                            v0[i] = __logf(lbv[bj][0][i] + (1.0f - lbv[bj][0][i]) * s0); v1[i] = __logf(lbv[bj][1][i] + (1.0f - lbv[bj][1][i]) * s1);
                        }
                        w.x = ::pack_h2(v0[0], v0[1]); w.y = ::pack_h2(v0[2], v0[3]); w.z = ::pack_h2(v1[0], v1[1]); w.w = ::pack_h2(v1[2], v1[3]);
                    } else {
                        if (tr == 1) {
#pragma unroll
                            for (int i = 0; i < 4; ++i) { v0[i] = ::fsilu(v0[i]); v1[i] = ::fsilu(v1[i]); }
                        }
                        w.x = ::cvt_pk_bf16(v0[0], v0[1]); w.y = ::cvt_pk_bf16(v0[2], v0[3]); w.z = ::cvt_pk_bf16(v1[0], v1[1]); w.w = ::cvt_pk_bf16(v1[2], v1[3]);
                    }
                    *(u32x4*)(rowp + bj * HALF) = w;
                }
            }
    }
};
struct EpiResid {
    static constexpr bool PERM = true, AFTER_DRAIN = false;
    _Float16* X; unsigned char* wsb; const float* modg; float coef; int permute; int skip_ctx;
    __device__ __forceinline__ void operator()(const f32x4 (&acc)[2][2][4][2], const Unit& u, int wr, int wc, int fr, int fq) const {
        const int base = u.pm * BM; const bool is_ctx = base >= ::ML; const int b = is_ctx ? 8 : (base >> 12);
        if (is_ctx && skip_ctx) return;
        const int col0 = u.pn * BM + wc * 32 + 8 * fq;
        const float* gp = modg + (size_t)b * 9216 + col0;
        f32x4 g0[2], g1[2];
#pragma unroll
        for (int bj = 0; bj < 2; ++bj) { g0[bj] = *(const f32x4*)(gp + bj * HALF) * coef; g1[bj] = *(const f32x4*)(gp + bj * HALF + 4) * coef; }
        if (u.sp >= 0) {
#pragma unroll
            for (int ai = 0; ai < 2; ++ai)
#pragma unroll
                for (int m = 0; m < 4; ++m) {
                    const int row = base + ai * HALF + wr * 64 + m * 16 + fr;
                    _Float16* pp = (_Float16*)(wsb + ::WS_OACC) + ((size_t)u.sp * ::MC + (row - ::ML)) * ::D + col0;
#pragma unroll
                    for (int bj = 0; bj < 2; ++bj) ::st_h8(pp + bj * HALF, g0[bj] * acc[ai][bj][m][0], g1[bj] * acc[ai][bj][m][1]);
                }
            return;
        }
#pragma unroll
        for (int ai = 0; ai < 2; ++ai)
#pragma unroll
            for (int m = 0; m < 4; ++m) {
                const int row = base + ai * HALF + wr * 64 + m * 16 + fr;
                _Float16* xp = X + (size_t)((permute && !is_ctx) ? ::permrow(row) : row) * ::D + col0;
#pragma unroll
                for (int bj = 0; bj < 2; ++bj) { f32x4 lo, hi; ::ld_h8(xp + bj * HALF, lo, hi); ::st_h8(xp + bj * HALF, lo + g0[bj] * acc[ai][bj][m][0], hi + g1[bj] * acc[ai][bj][m][1]); }
                if (m & 1) asm volatile("" ::: "memory");
            }
    }
};
struct EpiGLU {
    static constexpr bool PERM = true, AFTER_DRAIN = false;
    _Float16* X; const float* modg; const float* bias; int skip_ctx;
    __device__ __forceinline__ void operator()(const f32x4 (&acc)[2][2][4][2], const Unit& u, int wr, int wc, int fr, int fq) const {
        const int base = u.pm * BM; const bool is_ctx = base >= ::ML; const int b = is_ctx ? 8 : (base >> 12);
        if (is_ctx && skip_ctx) return;
        const int col0 = u.pn * 128 + wc * 32 + 8 * fq;
        const float* gp = modg + (size_t)b * 9216 + col0;
        f32x4 gv[2], bv[2], bg[2];
#pragma unroll
        for (int n = 0; n < 2; ++n) { gv[n] = *(const f32x4*)(gp + 4 * n); bv[n] = *(const f32x4*)(bias + col0 + 4 * n); bg[n] = *(const f32x4*)(bias + ::D + col0 + 4 * n); }
#pragma unroll
        for (int ai = 0; ai < 2; ++ai)
#pragma unroll
            for (int m = 0; m < 4; ++m) {
                const int row = base + ai * HALF + wr * 64 + m * 16 + fr;
                _Float16* xp = X + (size_t)row * ::D + col0;
                f32x4 y[2];
#pragma unroll
                for (int n = 0; n < 2; ++n) {
                    const f32x4 val = acc[ai][0][m][n] + bv[n], gt = acc[ai][1][m][n] + bg[n];
#pragma unroll
                    for (int i = 0; i < 4; ++i) y[n][i] = val[i] * ::fsigmoid(gt[i]);
                }
                f32x4 lo, hi; ::ld_h8(xp, lo, hi); ::st_h8(xp, lo + gv[0] * y[0], hi + gv[1] * y[1]);
            }
    }
};
template <class Epi, class Sched, bool ALIGN_EPI = false, bool SP2 = false>
__device__ __forceinline__ void gemm_phase(PG8_LAS unsigned char* lds, const Gemm g, const Sched& S, const Epi& E) {
    int tid_l = threadIdx.x; asm volatile("" : "+v"(tid_l)); const int tid = tid_l, wid = __builtin_amdgcn_readfirstlane(tid >> 6), lane = tid & 63, wr = wid >> 2, wc = wid & 3, fr = lane & 15, fq = lane >> 4;
    const int K = g.K;
    unsigned voffA[2], voffB[2];
#pragma unroll
    for (int i = 0; i < 2; ++i) { int R, C; stage_rc(tid * 16 + i * 8192, R, C); const int Rb = Epi::PERM ? ((R & ~31) + perm32(R & 31)) : R;
        voffA[i] = (unsigned)(R * K + C) * 2u; voffB[i] = (unsigned)(Rb * K + C) * 2u; }
    const size_t kstep = (size_t)(BK * 2);
    const size_t hstep = (size_t)HALF * K * 2;
    const size_t tstep = 2 * hstep;
    const unsigned ldsw = (unsigned)wid * 1024u;
    const int aoff = lds_byte(wr * 64 + fr, fq * 8), boff = lds_byte(wc * 32 + fr, fq * 8);
#define PG8_SA(b, h) (((b) * 2 + (h)) * HTB)
#define PG8_SB(b, h) ((4 + (b) * 2 + (h)) * HTB)
#define PG8_STAGE(bufoff, gbase, voff) do { _Pragma("unroll") for (int _i = 0; _i < 2; ++_i) \
        __builtin_amdgcn_global_load_lds((const unsigned*)((const char*)(gbase) + (voff)[_i]), (PG8_LAS unsigned*)(lds + (bufoff) + ldsw + _i * 8192), 16, 0, 0); } while (0)
#define PG8_LDA(dst, b, h) do { _Pragma("unroll") for (int m = 0; m < 4; ++m) _Pragma("unroll") for (int k = 0; k < 2; ++k) dst[m][k] = *(const PG8_LAS bf16x8*)(lds + PG8_SA(b, h) + aoff + m * 2048 + k * 1024); } while (0)
#define PG8_LDB(dst, b, h) do { _Pragma("unroll") for (int n = 0; n < 2; ++n) _Pragma("unroll") for (int k = 0; k < 2; ++k) dst[n][k] = *(const PG8_LAS bf16x8*)(lds + PG8_SB(b, h) + boff + n * 2048 + k * 1024); } while (0)
#define PG8_MMA(ai, bj, At, Bt) do { __builtin_amdgcn_s_setprio(1); _Pragma("unroll") for (int m = 0; m < 4; ++m) _Pragma("unroll") for (int n = 0; n < 2; ++n) _Pragma("unroll") for (int k = 0; k < 2; ++k) \
        acc[ai][bj][m][n] = __builtin_amdgcn_mfma_f32_16x16x32_bf16(Bt[n][k], At[m][k], acc[ai][bj][m][n], 0, 0, 0); __builtin_amdgcn_s_setprio(0); } while (0)
#define PG8_WAIT_V(n) asm volatile("s_waitcnt vmcnt(" #n ")" ::: "memory")
#define PG8_WAIT_L(n) asm volatile("s_waitcnt lgkmcnt(" #n ")" ::: "memory")
#define PG8_BAR __builtin_amdgcn_s_barrier()
#define PG8_SCHED __builtin_amdgcn_sched_barrier(0)
    Unit cur, nxt; int ui = 0;
    if (!S.next(0, cur)) return;
    f32x4 acc[2][2][4][2];
#pragma unroll
    for (int a = 0; a < 2; ++a)
#pragma unroll
        for (int b = 0; b < 2; ++b)
#pragma unroll
            for (int m = 0; m < 4; ++m)
#pragma unroll
                for (int n = 0; n < 2; ++n) acc[a][b][m][n] = (f32x4){0.f, 0.f, 0.f, 0.f};
    bf16x8 At[4][2], B0[2][2], B1[2][2];
    const char* cA = (const char*)g.A + (size_t)cur.pm * tstep + (size_t)cur.k0 * kstep; const char* cB = (const char*)g.Bt + (size_t)cur.pn * tstep + (size_t)cur.k0 * kstep;
    S.a_ready(cur);
    if constexpr (SP2) {
        PG8_STAGE(PG8_SB(0, 0), cB, voffB); PG8_STAGE(PG8_SB(0, 1), cB + hstep, voffB); PG8_STAGE(PG8_SA(0, 0), cA, voffA); PG8_STAGE(PG8_SA(0, 1), cA + hstep, voffA);
        if (wr == 1) PG8_BAR;
        PG8_WAIT_V(2); PG8_BAR;
        PG8_STAGE(PG8_SB(1, 0), cB + kstep, voffB); PG8_STAGE(PG8_SA(1, 0), cA + kstep, voffA); PG8_STAGE(PG8_SB(1, 1), cB + hstep + kstep, voffB);
        PG8_WAIT_V(6); PG8_BAR;
    } else {
        PG8_STAGE(PG8_SB(0, 0), cB, voffB); PG8_STAGE(PG8_SA(0, 0), cA, voffA); PG8_STAGE(PG8_SB(0, 1), cB + hstep, voffB); PG8_STAGE(PG8_SA(0, 1), cA + hstep, voffA);
        if (wr == 1) PG8_BAR;
        PG8_WAIT_V(4); PG8_BAR;
        PG8_STAGE(PG8_SB(1, 0), cB + kstep, voffB); PG8_STAGE(PG8_SA(1, 0), cA + kstep, voffA); PG8_STAGE(PG8_SB(1, 1), cB + hstep + kstep, voffB);
        PG8_WAIT_V(6); PG8_BAR;
    }
    for (;;) {
        const bool has_next = S.next(ui + 1, nxt);
        const char* nA = has_next ? (const char*)g.A + (size_t)nxt.pm * tstep + (size_t)nxt.k0 * kstep : cA; const char* nB = has_next ? (const char*)g.Bt + (size_t)nxt.pn * tstep + (size_t)nxt.k0 * kstep : cB;
        const int nt = cur.nt;
        for (int t = 0; t < nt; t += 2) {
            const bool last = (t == nt - 2);
            const char* a1 = cA + (size_t)(t + 1) * kstep;
            const char* a2 = last ? nA : cA + (size_t)(t + 2) * kstep; const char* b2 = last ? nB : cB + (size_t)(t + 2) * kstep;
            const char* a3 = a2 + kstep; const char* b3 = b2 + kstep;
            if (last && has_next) S.a_ready(nxt);
            if constexpr (SP2) {
            PG8_LDB(B0, 0, 0); PG8_LDB(B1, 0, 1); PG8_SCHED; PG8_LDA(At, 0, 0); PG8_STAGE(PG8_SA(1, 1), a1 + hstep, voffA);
            PG8_WAIT_V(8); PG8_WAIT_L(0); PG8_BAR; PG8_MMA(0, 0, At, B0); PG8_MMA(0, 1, At, B1); PG8_BAR; PG8_SCHED;
            PG8_LDA(At, 0, 1); PG8_STAGE(PG8_SB(0, 0), b2, voffB); PG8_STAGE(PG8_SB(0, 1), b2 + hstep, voffB); PG8_STAGE(PG8_SA(0, 0), a2, voffA);
            PG8_WAIT_V(8); PG8_WAIT_L(0); PG8_BAR; PG8_MMA(1, 0, At, B0); PG8_MMA(1, 1, At, B1); PG8_BAR; PG8_SCHED;
            PG8_LDB(B0, 1, 0); PG8_LDB(B1, 1, 1); PG8_SCHED; PG8_LDA(At, 1, 0); PG8_STAGE(PG8_SA(0, 1), a2 + hstep, voffA);
            PG8_WAIT_V(8); PG8_WAIT_L(0); PG8_BAR; PG8_MMA(0, 0, At, B0); PG8_MMA(0, 1, At, B1); PG8_BAR; PG8_SCHED;
            PG8_LDA(At, 1, 1); PG8_STAGE(PG8_SB(1, 0), b3, voffB); PG8_STAGE(PG8_SB(1, 1), b3 + hstep, voffB); PG8_STAGE(PG8_SA(1, 0), a3, voffA);
            PG8_WAIT_V(8); PG8_WAIT_L(0); PG8_BAR; PG8_MMA(1, 0, At, B0); PG8_MMA(1, 1, At, B1); PG8_BAR; PG8_SCHED;
            } else {
            PG8_LDB(B0, 0, 0); PG8_SCHED; PG8_LDA(At, 0, 0); PG8_STAGE(PG8_SA(1, 1), a1 + hstep, voffA);
            PG8_WAIT_L(8); PG8_BAR; PG8_WAIT_L(0); PG8_MMA(0, 0, At, B0); PG8_BAR; PG8_SCHED;
            PG8_LDB(B1, 0, 1); PG8_STAGE(PG8_SB(0, 0), b2, voffB);
            PG8_BAR; PG8_WAIT_L(0); PG8_MMA(0, 1, At, B1); PG8_BAR;
            PG8_LDA(At, 0, 1); PG8_STAGE(PG8_SA(0, 0), a2, voffA);
            PG8_BAR; PG8_WAIT_L(0); PG8_MMA(1, 0, At, B0); PG8_BAR; PG8_SCHED;
            PG8_STAGE(PG8_SB(0, 1), b2 + hstep, voffB);
            PG8_WAIT_V(6); PG8_BAR; PG8_MMA(1, 1, At, B1); PG8_BAR;
            PG8_LDB(B0, 1, 0); PG8_SCHED; PG8_LDA(At, 1, 0); PG8_STAGE(PG8_SA(0, 1), a2 + hstep, voffA);
            PG8_WAIT_L(8); PG8_BAR; PG8_WAIT_L(0); PG8_MMA(0, 0, At, B0); PG8_BAR; PG8_SCHED;
            PG8_LDB(B1, 1, 1); PG8_STAGE(PG8_SB(1, 0), b3, voffB);
            PG8_BAR; PG8_WAIT_L(0); PG8_MMA(0, 1, At, B1); PG8_BAR;
            PG8_LDA(At, 1, 1); PG8_STAGE(PG8_SA(1, 0), a3, voffA);
            PG8_BAR; PG8_WAIT_L(0); PG8_MMA(1, 0, At, B0); PG8_BAR; PG8_SCHED;
            PG8_STAGE(PG8_SB(1, 1), b3 + hstep, voffB);
            PG8_WAIT_V(6); PG8_BAR; PG8_MMA(1, 1, At, B1); PG8_BAR;
            }
        }
        if constexpr (ALIGN_EPI) { if (wr == 0) PG8_BAR; }
        if constexpr (!Epi::AFTER_DRAIN) { E(acc, cur, wr, wc, fr, fq); S.done(cur); }
        if (!has_next) break;
#pragma unroll
        for (int a = 0; a < 2; ++a)
#pragma unroll
            for (int b = 0; b < 2; ++b)
#pragma unroll
                for (int m = 0; m < 4; ++m)
#pragma unroll
                    for (int n = 0; n < 2; ++n) acc[a][b][m][n] = (f32x4){0.f, 0.f, 0.f, 0.f};
        cur = nxt; cA = nA; cB = nB; ++ui;
        if constexpr (ALIGN_EPI) { if (wr == 1) PG8_BAR; }
    }
    PG8_WAIT_V(0);
    if constexpr (!ALIGN_EPI) { if (wr == 0) PG8_BAR; }
    PG8_BAR;
    if constexpr (Epi::AFTER_DRAIN) { E.fused(acc, cur, wr, wc, fr, fq, lds, wid, lane); S.done(cur); }
#undef PG8_SA
#undef PG8_SB
#undef PG8_STAGE
#undef PG8_LDA
#undef PG8_LDB
#undef PG8_MMA
#undef PG8_WAIT_V
#undef PG8_WAIT_L
#undef PG8_BAR
#undef PG8_SCHED
}
}

struct Ctx {
    const Params* p; LAS unsigned char* lds; int tid, lane, wid, G, bid;
    _Float16* X; float* outp; float* mod; float* lb; bf16_t* H; unsigned char* big; unsigned char* oacc;
};

__device__ __forceinline__ void conv_w(const Ctx& c, const float* src, int ldsrc, int K, bf16_t* dst, int Ndst, int mode, int half, int item0, int& items_done) {
    LAS float* tile = (LAS float*)c.lds;
    const int nkt = K / 128, ntiles = (Ndst / 64) * nkt;
    for (int t = c.bid; t < ntiles; t += c.G) {
        const int nt = t / nkt, kt = t % nkt, nbase = nt * 64, kbase = kt * 128;
        {
            const int n4 = (c.tid & 15) * 4, kr = c.tid >> 4; const int nd = nbase + n4; int sc; float scale = 1.f; bool valid = true;
            if (mode == 1) { const int pn = nd >> 8, jj = nd & 255; sc = (jj < 128) ? pn * 128 + jj : half + pn * 128 + jj - 128; }
            else if (mode == 2) { sc = nd; valid = nd < 3104; if (nd < 512) scale = 0.08838834764831845f; }
            else sc = nd;
            f32x4 v[4];
#pragma unroll
            for (int ps = 0; ps < 4; ++ps) v[ps] = valid ? __builtin_nontemporal_load((const f32x4*)(src + (size_t)(kbase + kr + 32 * ps) * ldsrc + sc)) : (f32x4){0.f, 0.f, 0.f, 0.f};
#pragma unroll
            for (int ps = 0; ps < 4; ++ps) { LAS float* tp = tile + (kr + 32 * ps) * 65 + n4; tp[0] = v[ps][0] * scale; tp[1] = v[ps][1] * scale; tp[2] = v[ps][2] * scale; tp[3] = v[ps][3] * scale; }
        }
        __syncthreads();
        {
            const int n = c.tid >> 3, k16 = (c.tid & 7) * 16; unsigned w[8];
#pragma unroll
            for (int i = 0; i < 8; ++i) w[i] = cvt_pk_bf16(tile[(k16 + 2 * i) * 65 + n], tile[(k16 + 2 * i + 1) * 65 + n]);
            bf16_t* dp = dst + (size_t)(nbase + n) * K + kbase + k16;
            *(u32x4*)dp = (u32x4){w[0], w[1], w[2], w[3]}; *(u32x4*)(dp + 8) = (u32x4){w[4], w[5], w[6], w[7]};
        }
        __syncthreads();
    }
}
__device__ __forceinline__ void conv_ffn(const Ctx& c, int layer) {
    const float* wi = c.p->in[7] + (size_t)layer * 2 * D * 2 * DFF; const float* wo = c.p->in[8] + (size_t)layer * 2 * DFF * D; int dummy = 0;
    for (int s = 0; s < 2; ++s) {
        conv_w(c, wi + (size_t)s * D * 2 * DFF, 2 * DFF, D, (bf16_t*)(c.p->ws + WS_WFI) + (size_t)s * 2 * DFF * D, 2 * DFF, 1, DFF, 0, dummy);
        conv_w(c, wo + (size_t)s * DFF * D, D, DFF, (bf16_t*)(c.p->ws + WS_WFO) + (size_t)s * D * DFF, D, 0, 0, 0, dummy);
    }
}

__device__ __forceinline__ void phase_prep(const Ctx& c) {
    for (int e = c.bid * NTHR + c.tid; e < 2 * D; e += c.G * NTHR) {
        const float* lg = c.p->in[25]; float v[4], mx = -1e30f;
        for (int l = 0; l < 4; ++l) { v[l] = lg[(size_t)l * 2 * D + e]; mx = fmaxf(mx, v[l]); }
        float s = 0.f; for (int l = 0; l < 4; ++l) { v[l] = expf(v[l] - mx); s += v[l]; }
        c.lb[e] = (v[1] + v[2]) / s;
    }
    {
        LAS float* sc = (LAS float*)c.lds;
        LAS float* red = sc + 9 * 1024;
        for (int e = c.tid; e < 9 * 1024; e += NTHR) { const int r = e >> 10, k = e & 1023; const float v = r < 8 ? c.p->in[1][r * D + k] : c.p->in[3][k]; sc[e] = v / (1.0f + expf(-v)); }
        __syncthreads();
        for (int it = c.bid; it < 4 * 144; it += c.G) {
            const int l = it / 144, cg_ = it % 144, col = c.tid & 63, ks = c.tid >> 6;
            const float* w = c.p->in[4] + (size_t)l * D * 9216 + (size_t)(ks * 128) * 9216 + cg_ * 64 + col;
            float a[9];
#pragma unroll
            for (int r = 0; r < 9; ++r) a[r] = 0.f;
            for (int k0 = 0; k0 < 128; k0 += 16) { float wv[16];
#pragma unroll
                for (int kk = 0; kk < 16; ++kk) wv[kk] = __builtin_nontemporal_load(w + (size_t)(k0 + kk) * 9216);
#pragma unroll
                for (int r = 0; r < 9; ++r) {
#pragma unroll
                    for (int q = 0; q < 4; ++q) { const f32x4 s4 = *(const LAS f32x4*)(sc + r * 1024 + ks * 128 + k0 + 4 * q); a[r] += (s4[0] * wv[4 * q] + s4[1] * wv[4 * q + 1]) + (s4[2] * wv[4 * q + 2] + s4[3] * wv[4 * q + 3]); } } }
#pragma unroll
            for (int r = 0; r < 9; ++r) red[(ks * 9 + r) * 64 + col] = a[r];
            __syncthreads();
            for (int e = c.tid; e < 9 * 64; e += NTHR) { const int r = e >> 6, cc = e & 63; float s = c.p->in[5][(size_t)l * 9216 + cg_ * 64 + cc];
                for (int q = 0; q < 8; ++q) s += red[(q * 9 + r) * 64 + cc];
                c.mod[((size_t)l * 9 + r) * 9216 + cg_ * 64 + cc] = s; }
            __syncthreads();
        }
    }
    int dummy = 0;
    for (int j = 0; j < 2; ++j) conv_w(c, c.p->in[17] + (size_t)j * D * 2 * D, 2 * D, D, (bf16_t*)(c.p->ws + WS_WGLU) + (size_t)j * 2 * D * D, 2 * D, 1, D, 0, dummy);
    conv_w(c, c.p->in[19], 3104, D, (bf16_t*)(c.p->ws + WS_WGI), 3328, 2, 0, 0, dummy);
    conv_w(c, c.p->in[23], D, D, (bf16_t*)(c.p->ws + WS_WGO), D, 0, 0, 0, dummy);
    conv_w(c, c.p->in[24], 5 * D, D, (bf16_t*)(c.p->ws + WS_WHI), 5 * D, 0, 0, 0, dummy);
    conv_w(c, c.p->in[27], D, D, (bf16_t*)(c.p->ws + WS_WHO), D, 0, 0, 0, dummy);
    conv_ffn(c, 0);
}

__device__ __forceinline__ void phase_norm(const Ctx& c, int layer, int sub, bool from_input, bool permute, int nparts, int nrows, int row_lo) {
    const float* w = c.p->in[6] + ((size_t)layer * 3 + sub) * D;
    const float* modl = c.mod + (size_t)layer * 9 * 9216;
    for (int row = row_lo + c.bid * 8 + c.wid; row < nrows; row += c.G * 8) {
        const int b = row < ML ? (row >> 12) : 8;
        _Float16* xr = c.X + (size_t)row * D;
        f32x4 v[4]; float ss = 0.f;
        if (from_input) { const float* src = row < ML ? c.p->in[0] + (size_t)row * D : c.p->in[2] + (size_t)(row - ML) * D;
#pragma unroll
            for (int j = 0; j < 4; ++j) { v[j] = __builtin_nontemporal_load((const f32x4*)(src + j * 256 + c.lane * 4)); st_h4(xr + j * 256 + c.lane * 4, v[j]); }
        } else {
#pragma unroll
            for (int j = 0; j < 4; ++j) { const u32x2 w = __builtin_nontemporal_load((const u32x2*)(xr + j * 256 + c.lane * 4)); v[j] = (f32x4){h2lo(w.x), h2hi(w.x), h2lo(w.y), h2hi(w.y)}; }
        }
        if (nparts > 0 && row >= ML) {
            const _Float16* pp = (const _Float16*)c.oacc + (size_t)(row - ML) * D;
            for (int s = 0; s < nparts; ++s)
#pragma unroll
                for (int j = 0; j < 4; ++j) { const u32x2 w = __builtin_nontemporal_load((const u32x2*)(pp + (size_t)s * MC * D + j * 256 + c.lane * 4)); v[j] += (f32x4){h2lo(w.x), h2hi(w.x), h2lo(w.y), h2hi(w.y)}; }
#pragma unroll
            for (int j = 0; j < 4; ++j) st_h4(xr + j * 256 + c.lane * 4, v[j]);
        }
#pragma unroll
        for (int j = 0; j < 4; ++j) ss += v[j][0] * v[j][0] + v[j][1] * v[j][1] + v[j][2] * v[j][2] + v[j][3] * v[j][3];
#pragma unroll
        for (int o = 32; o >= 1; o >>= 1) ss += shfl_xor_l(ss, o, c.lane);
        const float rstd = rsqrtf(ss * (1.0f / D) + 1e-6f);
        const float* sh = modl + (size_t)b * 9216 + (sub * 3) * 1024; const float* scl = sh + 1024;
        const int drow = (permute && row < ML) ? permrow(row) : row;
        bf16_t* hp = c.H + (size_t)drow * D;
#pragma unroll
        for (int j = 0; j < 4; ++j) { const int col = j * 256 + c.lane * 4;
            const f32x4 wv = *(const f32x4*)(w + col), sv = *(const f32x4*)(scl + col), hv = *(const f32x4*)(sh + col);
            f32x4 y = v[j] * rstd * wv * (sv + 1.0f) + hv;
            u32x2 o; o.x = cvt_pk_bf16(y[0], y[1]); o.y = cvt_pk_bf16(y[2], y[3]); *(u32x2*)(hp + col) = o; }
    }
}
__device__ __forceinline__ void phase_final(const Ctx& c) {
    const float* w = c.p->in[28];
    for (int row = c.bid * 8 + c.wid; row < ML; row += c.G * 8) {
        const _Float16* xr = c.X + (size_t)row * D; float* op = c.outp + (size_t)row * D; f32x4 v[4]; float ss = 0.f;
#pragma unroll
        for (int j = 0; j < 4; ++j) { const u32x2 wv = __builtin_nontemporal_load((const u32x2*)(xr + j * 256 + c.lane * 4)); v[j] = (f32x4){h2lo(wv.x), h2hi(wv.x), h2lo(wv.y), h2hi(wv.y)}; ss += v[j][0] * v[j][0] + v[j][1] * v[j][1] + v[j][2] * v[j][2] + v[j][3] * v[j][3]; }
#pragma unroll
        for (int o = 32; o >= 1; o >>= 1) ss += shfl_xor_l(ss, o, c.lane);
        const float rstd = rsqrtf(ss * (1.0f / D) + 1e-6f);
#pragma unroll
        for (int j = 0; j < 4; ++j) { const int col = j * 256 + c.lane * 4; __builtin_nontemporal_store(v[j] * rstd * *(const f32x4*)(w + col), (f32x4*)(op + col)); }
    }
}

__device__ __forceinline__ int s5_row(int b, int dir, int ci, int t) {
    if (ci < 8) { const int s = ci * 32 + t; return ML + b * CTXL + (dir ? (CTXL - 1 - s) : s); }
    const int s = (ci - 8) * 32 + t; return b * SEQ + (dir ? (SEQ - 1 - s) : s);
}
__device__ __forceinline__ void phase_s5_scan(const Ctx& c, int j) {
    if (c.wid >= 4) return;
    constexpr int LDW = 132;
    LAS float* buf = (LAS float*)c.lds + c.wid * 32 * LDW;
    const int l = c.lane;
    bf16_t* Yf = (bf16_t*)c.big; bf16_t* Yb = Yf + (size_t)MT * D;
    for (int unit = c.bid * 4 + c.wid; unit < NB * 64 * 2; unit += c.G * 4) {
        const int dir = unit & 1, g = (unit >> 1) & 63, b = unit >> 7;
        const size_t gi = ((size_t)j * 2 + dir) * 64 + g;
        const float dt = expf(c.p->in[11][gi]);
        bf16x8 Bop[4];
#pragma unroll
        for (int ph = 0; ph < 2; ++ph) {
            const int pp = ph * 32 + (l & 31);
            const float are = c.p->in[9][gi * 64 + pp], aim = c.p->in[10][gi * 64 + pp];
            const float mag = expf(are * dt), abr = mag * cosf(aim * dt), abi = mag * sinf(aim * dt), den = are * are + aim * aim;
            const float zr = abr - 1.0f, zi = abi, cre = (zr * are + zi * aim) / den, cim = (zi * are - zr * aim) / den;
            const float* bre = c.p->in[12] + (gi * 64 + pp) * 16 + 8 * (l >> 5); const float* bim = c.p->in[13] + (gi * 64 + pp) * 16 + 8 * (l >> 5);
#pragma unroll
            for (int e = 0; e < 8; ++e) { const float br = bre[e], bi = bim[e];
                Bop[ph][e] = (short)f2bf(cre * br - cim * bi); Bop[2 + ph][e] = (short)f2bf(cre * bi + cim * br); }
        }
        float ar, ai;
        { const float are = c.p->in[9][gi * 64 + l], aim = c.p->in[10][gi * 64 + l]; const float mag = expf(are * dt); ar = mag * cosf(aim * dt); ai = mag * sinf(aim * dt); }
        bf16x8 Cop[4];
#pragma unroll
        for (int ks = 0; ks < 4; ++ks) {
            const int p0 = 32 * ks + 8 * (l >> 4); const int cc = l & 15;
            const float* src = (p0 < 64) ? c.p->in[14] + (gi * 16 + cc) * 64 + p0 : c.p->in[15] + (gi * 16 + cc) * 64 + (p0 - 64);
            const float sg = (p0 < 64) ? 1.0f : -1.0f;
#pragma unroll
            for (int e = 0; e < 8; ++e) Cop[ks][e] = (short)f2bf(sg * src[e]);
        }
        bf16_t* Y = dir ? Yb : Yf;
        float hr = 0.f, hi = 0.f;
        bf16x8 Aring[4];
#pragma unroll
        for (int q = 0; q < 4; ++q) Aring[q] = *(const bf16x8*)(c.H + (size_t)s5_row(b, dir, q, l & 31) * D + g * 16 + 8 * (l >> 5));
        for (int ci0 = 0; ci0 < 136; ci0 += 4) {
#pragma unroll
          for (int cq = 0; cq < 4; ++cq) {
            const int ci = ci0 + cq;
            const bf16x8 A = Aring[cq];
            if (ci + 4 < 136) Aring[cq] = *(const bf16x8*)(c.H + (size_t)s5_row(b, dir, ci + 4, l & 31) * D + g * 16 + 8 * (l >> 5));
#pragma unroll
            for (int nt = 0; nt < 4; ++nt) {
                f32x16 acc;
#pragma unroll
                for (int i = 0; i < 16; ++i) acc[i] = 0.f;
                acc = __builtin_amdgcn_mfma_f32_32x32x16_bf16(A, Bop[nt], acc, 0, 0, 0);
#pragma unroll
                for (int i = 0; i < 16; ++i) { const int t = (i & 3) + 8 * (i >> 2) + 4 * (l >> 5); buf[t * LDW + 32 * nt + (l & 31)] = acc[i]; }
            }
            __builtin_amdgcn_fence(__ATOMIC_RELEASE, "wavefront"); __builtin_amdgcn_wave_barrier();
            {
                float br[32], bi[32];
#pragma unroll
                for (int t = 0; t < 32; ++t) { br[t] = buf[t * LDW + l]; bi[t] = buf[t * LDW + 64 + l]; }
#pragma unroll
                for (int t = 0; t < 32; ++t) { const float nr = ar * hr - ai * hi + br[t], ni = ar * hi + ai * hr + bi[t]; hr = nr; hi = ni; br[t] = hr; bi[t] = hi; }
#pragma unroll
                for (int t = 0; t < 32; ++t) { buf[t * LDW + l] = br[t]; buf[t * LDW + 64 + l] = bi[t]; }
            }
            __builtin_amdgcn_fence(__ATOMIC_RELEASE, "wavefront"); __builtin_amdgcn_wave_barrier();
#pragma unroll
            for (int mt = 0; mt < 2; ++mt) {
                f32x4 acc = {0.f, 0.f, 0.f, 0.f};
#pragma unroll
                for (int ks = 0; ks < 4; ++ks) {
                    const LAS float* hp = buf + (16 * mt + (l & 15)) * LDW + 32 * ks + 8 * (l >> 4);
                    const f32x4 h0 = *(const LAS f32x4*)hp, h1 = *(const LAS f32x4*)(hp + 4);
                    union { u32x4 u; bf16x8 v; } cv; cv.u.x = cvt_pk_bf16(h0[0], h0[1]); cv.u.y = cvt_pk_bf16(h0[2], h0[3]); cv.u.z = cvt_pk_bf16(h1[0], h1[1]); cv.u.w = cvt_pk_bf16(h1[2], h1[3]);
                    acc = __builtin_amdgcn_mfma_f32_16x16x32_bf16(cv.v, Cop[ks], acc, 0, 0, 0);
                }
#pragma unroll
                for (int i = 0; i < 4; ++i) { const int t = 16 * mt + 4 * (l >> 4) + i; Y[(size_t)s5_row(b, dir, ci, t) * D + g * 16 + (l & 15)] = f2bf(acc[i]); }
            }
            __builtin_amdgcn_fence(__ATOMIC_RELEASE, "wavefront"); __builtin_amdgcn_wave_barrier();
          }
        }
    }
}
__device__ __forceinline__ void phase_s5_post(const Ctx& c, int j) {
    const bf16_t* Yf = (const bf16_t*)c.big; const bf16_t* Yb = Yf + (size_t)MT * D; bf16_t* Gb = (bf16_t*)c.oacc; const float* dsk = c.p->in[16] + (size_t)j * D;
    const size_t n8 = (size_t)MT * D / 8;
    for (size_t e = (size_t)c.bid * NTHR + c.tid; e < n8; e += (size_t)c.G * NTHR) {
        const size_t off = e * 8; const int col = (int)(off & (D - 1));
        const u32x4 av = __builtin_nontemporal_load((const u32x4*)(Yf + off)), bv = __builtin_nontemporal_load((const u32x4*)(Yb + off));
        const f32x4 d0 = *(const f32x4*)(dsk + col), d1 = *(const f32x4*)(dsk + col + 4);
        const u32x4 hv = __builtin_nontemporal_load((const u32x4*)(c.H + off));
        float y[8];
        y[0] = bflo(av.x) + bflo(bv.x) + d0[0] * bflo(hv.x); y[1] = bfhi(av.x) + bfhi(bv.x) + d0[1] * bfhi(hv.x); y[2] = bflo(av.y) + bflo(bv.y) + d0[2] * bflo(hv.y); y[3] = bfhi(av.y) + bfhi(bv.y) + d0[3] * bfhi(hv.y);
        y[4] = bflo(av.z) + bflo(bv.z) + d1[0] * bflo(hv.z); y[5] = bfhi(av.z) + bfhi(bv.z) + d1[1] * bfhi(hv.z); y[6] = bflo(av.w) + bflo(bv.w) + d1[2] * bflo(hv.w); y[7] = bfhi(av.w) + bfhi(bv.w) + d1[3] * bfhi(hv.w);
#pragma unroll
        for (int i = 0; i < 8; ++i) { const float x = y[i]; const float t = 0.7978845608028654f * (x + 0.044715f * x * x * x); const float th = 1.0f - 2.0f * __builtin_amdgcn_rcpf(1.0f + __expf(2.0f * t)); y[i] = 0.5f * x * (1.0f + th); }
        u32x4 o; o.x = cvt_pk_bf16(y[0], y[1]); o.y = cvt_pk_bf16(y[2], y[3]); o.z = cvt_pk_bf16(y[4], y[5]); o.w = cvt_pk_bf16(y[6], y[7]);
        *(u32x4*)(Gb + off) = o;
    }
}

template <bool GLA>
__device__ __forceinline__ void phase_scan_pre(const Ctx& c) {
    if (GLA) {
        const bf16_t* P = (const bf16_t*)c.big; unsigned* Hg = (unsigned*)c.H;
        const int dir = c.tid >> 8, kp = c.tid & 255;
        float w0[16], w1[16];
#pragma unroll
        for (int r = 0; r < 16; ++r) { w0[r] = c.p->in[20][((size_t)dir * 16 + r) * 512 + 2 * kp]; w1[r] = c.p->in[20][((size_t)dir * 16 + r) * 512 + 2 * kp + 1]; }
        const float b0 = c.p->in[21][dir * 512 + 2 * kp], b1 = c.p->in[21][dir * 512 + 2 * kp + 1];
        for (int row = c.bid; row < MT; row += c.G) {
            const u32x4 l0 = *(const u32x4*)(P + (size_t)row * 3328 + 3072 + dir * 16), l1 = *(const u32x4*)(P + (size_t)row * 3328 + 3072 + dir * 16 + 8);
            const unsigned lw[8] = {l0.x, l0.y, l0.z, l0.w, l1.x, l1.y, l1.z, l1.w};
            float p0 = b0, p1 = b1;
#pragma unroll
            for (int r = 0; r < 8; ++r) { const float a = bflo(lw[r]), bb = bfhi(lw[r]); p0 += a * w0[2 * r] + bb * w0[2 * r + 1]; p1 += a * w1[2 * r] + bb * w1[2 * r + 1]; }
            const float g0 = -(fmaxf(-p0, 0.f) + __logf(1.0f + __expf(-fabsf(p0)))) * 0.0625f, g1 = -(fmaxf(-p1, 0.f) + __logf(1.0f + __expf(-fabsf(p1)))) * 0.0625f;
            Hg[(size_t)row * 512 + dir * 256 + kp] = pack_h2(g0, g1);
        }
    } else {
        unsigned* P = (unsigned*)c.big;
        const int cp = c.tid;
        const float lf0 = c.lb[2 * cp], lf1 = c.lb[2 * cp + 1], lb0 = c.lb[D + 2 * cp], lb1 = c.lb[D + 2 * cp + 1];
        for (int row = c.bid; row < MT; row += c.G) {
            unsigned* pr = P + (size_t)row * 2560;
            const unsigned qw = pr[cp], zf = pr[1024 + cp], zb = pr[1536 + cp];
            pr[cp] = cvt_pk_bf16(fsilu(bflo(qw)), fsilu(bfhi(qw)));
            { const float s0 = fsigmoid(fminf(fmaxf(bflo(zf), -30.f), 30.f)), s1 = fsigmoid(fminf(fmaxf(bfhi(zf), -30.f), 30.f));
              pr[1024 + cp] = pack_h2(__logf(lf0 + (1.0f - lf0) * s0), __logf(lf1 + (1.0f - lf1) * s1)); }
            { const float s0 = fsigmoid(fminf(fmaxf(bflo(zb), -30.f), 30.f)), s1 = fsigmoid(fminf(fmaxf(bfhi(zb), -30.f), 30.f));
              pr[1536 + cp] = pack_h2(__logf(lb0 + (1.0f - lb0) * s0), __logf(lb1 + (1.0f - lb1) * s1)); }
        }
    }
}
template <bool GLA>
__device__ __forceinline__ void phase_chunk_scan(const Ctx& c) {
    constexpr int NH = GLA ? 4 : 8, DV = GLA ? 256 : 128, NSL = DV / 64, LDP = GLA ? 3328 : 5120;
    constexpr int QS = 272, KTS = 144;
    constexpr int OFF_KS = 64 * QS, OFF_KT = 2 * 64 * QS, OFF_VT = OFF_KT + 128 * KTS, OFF_EL = OFF_VT + 64 * KTS, BUFSZ = OFF_EL + 512;
    LAS unsigned char* L = c.lds;
    LAS unsigned char* Ss = L + 2 * BUFSZ;
    LAS unsigned char* StT = Ss + 64 * KTS;
    LAS float* part = (LAS float*)(StT + 64 * QS);
    static_assert(2 * BUFSZ + 64 * KTS + 64 * QS + 4096 <= LDS_MAIN, "chunk scan LDS");
    const bf16_t* P = (const bf16_t*)c.big;
    const unsigned* Hg = (const unsigned*)c.H;
    bf16_t* OF = (bf16_t*)c.oacc; bf16_t* OB = OF + (size_t)MT * D;
    const int tid = c.tid, l = c.lane, w = c.wid, kp = tid & 63, jg = tid >> 6;
    const int vcu = (c.G % 8 == 0) ? (c.bid % 8) * (c.G / 8) + c.bid / 8 : c.bid;
    for (int unit = vcu; unit < NB * NH * 2 * NSL; unit += c.G) {
        const int sl = unit % NSL, dir = (unit / NSL) & 1, h = (unit / (2 * NSL)) % NH, b = unit / (2 * NSL * NH);
        bf16_t* Oout = dir ? OB : OF;
        const int qcol = h * 128 + 2 * kp;
        const int kcol = 512 + h * 128 + 2 * kp;
        const int vcol = (GLA ? 1024 + h * 256 : 1024 + h * 128) + sl * 64;
        f32x4 st[4];
#pragma unroll
        for (int vt = 0; vt < 4; ++vt) st[vt] = (f32x4){0.f, 0.f, 0.f, 0.f};
        for (int e = tid; e < 64 * QS / 4; e += NTHR) ((LAS unsigned*)StT)[e] = 0u;
        unsigned nq[8], nk[8], ng[8]; u32x4 nv;
        unsigned rq[8], rk[8], rg[8]; u32x4 rv;
        float c0[8], c1[8];
#define CS_CB(ci) ((ci) < 4 ? ML + b * CTXL + (dir ? 3 - (ci) : (ci)) * 64 : b * SEQ + (dir ? 63 - ((ci) - 4) : ((ci) - 4)) * 64)
#define CS_LOAD(ci) do { const int cb_ = CS_CB(ci); \
            _Pragma("unroll") for (int jj = 0; jj < 8; ++jj) { const int jp_ = jg * 8 + jj; const size_t row_ = (size_t)(cb_ + (dir ? 63 - jp_ : jp_)); \
                nq[jj] = *(const unsigned*)(P + row_ * LDP + qcol); \
                if (GLA) { nk[jj] = *(const unsigned*)(P + row_ * LDP + kcol); ng[jj] = Hg[row_ * 512 + dir * 256 + h * 64 + kp]; } \
                else { ng[jj] = *(const unsigned*)(P + row_ * LDP + (2 + dir) * 1024 + qcol); nk[jj] = 0u; } } \
            { const int jp_ = tid & 63, v8_ = tid >> 6; const size_t row_ = (size_t)(cb_ + (dir ? 63 - jp_ : jp_)); nv = *(const u32x4*)(P + row_ * LDP + vcol + v8_ * 8); } } while (0)
#define CS_EW1(ci_next) do { rv = nv; \
            _Pragma("unroll") for (int jj = 0; jj < 8; ++jj) { rq[jj] = nq[jj]; rk[jj] = nk[jj]; rg[jj] = ng[jj]; } \
            if ((ci_next) < 68) CS_LOAD(ci_next); \
            float run0 = 0.f, run1 = 0.f; \
            _Pragma("unroll") for (int jj = 0; jj < 8; ++jj) { run0 += h2lo(rg[jj]); run1 += h2hi(rg[jj]); c0[jj] = run0; c1[jj] = run1; } \
            *(LAS f32v2_t*)(part + jg * 128 + 2 * kp) = (f32v2_t){run0, run1}; } while (0)
#define CS_EW2(B) do { LAS unsigned char* Qs_ = (B); LAS unsigned char* Ks_ = (B) + OFF_KS; LAS unsigned char* KT_ = (B) + OFF_KT; LAS unsigned char* VT_ = (B) + OFF_VT; LAS float* el_ = (LAS float*)((B) + OFF_EL); \
            float off0 = 0.f, off1 = 0.f, tot0 = 0.f, tot1 = 0.f; \
            _Pragma("unroll") for (int q = 0; q < 8; ++q) { const f32v2_t pv = *(const LAS f32v2_t*)(part + q * 128 + 2 * kp); tot0 += pv.x; tot1 += pv.y; if (q < jg) { off0 += pv.x; off1 += pv.y; } } \
            if (jg == 0) *(LAS f32v2_t*)(el_ + 2 * kp) = (f32v2_t){__expf(tot0), __expf(tot1)}; \
            float ka[8], kb[8]; \
            _Pragma("unroll") for (int jj = 0; jj < 8; ++jj) { \
                const float cu0 = off0 + c0[jj], cu1 = off1 + c1[jj]; \
                const float e0 = __expf(cu0), e1 = __expf(cu1), i0 = __expf(-cu0), i1 = __expf(-cu1); \
                float kk0, kk1; \
                if (GLA) { kk0 = bflo(rk[jj]); kk1 = bfhi(rk[jj]); } else { kk0 = 1.0f - __expf(h2lo(rg[jj])); kk1 = 1.0f - __expf(h2hi(rg[jj])); } \
                const float q0 = bflo(rq[jj]) * e0, q1 = bfhi(rq[jj]) * e1; \
                ka[jj] = kk0 * i0; kb[jj] = kk1 * i1; \
                const int jp = jg * 8 + jj; \
                *(LAS unsigned*)(Qs_ + jp * QS + kp * 4) = cvt_pk_bf16(q0, q1); \
                *(LAS unsigned*)(Ks_ + jp * QS + kp * 4) = cvt_pk_bf16(ka[jj], kb[jj]); } \
            *(LAS u32x4*)(KT_ + (2 * kp) * KTS + jg * 16) = (u32x4){cvt_pk_bf16(ka[0], ka[1]), cvt_pk_bf16(ka[2], ka[3]), cvt_pk_bf16(ka[4], ka[5]), cvt_pk_bf16(ka[6], ka[7])}; \
            *(LAS u32x4*)(KT_ + (2 * kp + 1) * KTS + jg * 16) = (u32x4){cvt_pk_bf16(kb[0], kb[1]), cvt_pk_bf16(kb[2], kb[3]), cvt_pk_bf16(kb[4], kb[5]), cvt_pk_bf16(kb[6], kb[7])}; \
            { const int jp = tid & 63, v8 = tid >> 6; const unsigned vw[4] = {rv.x, rv.y, rv.z, rv.w}; \
              _Pragma("unroll") for (int e = 0; e < 4; ++e) { *(LAS bf16_t*)(VT_ + (v8 * 8 + 2 * e) * KTS + jp * 2) = (bf16_t)(vw[e] & 0xffffu); *(LAS bf16_t*)(VT_ + (v8 * 8 + 2 * e + 1) * KTS + jp * 2) = (bf16_t)(vw[e] >> 16); } } } while (0)
        CS_LOAD(0);
        CS_EW1(1);
        __syncthreads();
        CS_EW2(L);
        __syncthreads();
        for (int ci = 0; ci < 68; ++ci) {
            const int cb = CS_CB(ci);
            LAS unsigned char* Bc = L + (ci & 1) * BUFSZ; LAS unsigned char* Bn = L + ((ci + 1) & 1) * BUFSZ;
            LAS unsigned char* Qs = Bc; LAS unsigned char* Ks = Bc + OFF_KS; LAS unsigned char* KT = Bc + OFF_KT; LAS unsigned char* VT = Bc + OFF_VT; LAS float* elast = (LAS float*)(Bc + OFF_EL);
            f32x4 oacc[2];
            if (w >= 4 && ci + 1 < 68) CS_EW1(ci + 2);
            {
                const int itS = w & 3, vtO = w & 3;
                bf16x8 qf[4], sf[4];
#pragma unroll
                for (int ks = 0; ks < 4; ++ks) { qf[ks] = *(const LAS bf16x8*)(Qs + (itS * 16 + (l & 15)) * QS + (ks * 32 + 8 * (l >> 4)) * 2); sf[ks] = *(const LAS bf16x8*)(StT + (vtO * 16 + (l & 15)) * QS + (ks * 32 + 8 * (l >> 4)) * 2); }
#pragma unroll
                for (int tt2 = 0; tt2 < 2; ++tt2) {
                    const int jt = (w >> 2) + 2 * tt2;
                    f32x4 s = {0.f, 0.f, 0.f, 0.f}, o = {0.f, 0.f, 0.f, 0.f};
                    if (jt <= itS) {
#pragma unroll
                        for (int ks = 0; ks < 4; ++ks) { const bf16x8 kf = *(const LAS bf16x8*)(Ks + (jt * 16 + (l & 15)) * QS + (ks * 32 + 8 * (l >> 4)) * 2); s = __builtin_amdgcn_mfma_f32_16x16x32_bf16(kf, qf[ks], s, 0, 0, 0); }
                    }
#pragma unroll
                    for (int ks = 0; ks < 4; ++ks) { const bf16x8 qo = *(const LAS bf16x8*)(Qs + (jt * 16 + (l & 15)) * QS + (ks * 32 + 8 * (l >> 4)) * 2); o = __builtin_amdgcn_mfma_f32_16x16x32_bf16(qo, sf[ks], o, 0, 0, 0); }
                    oacc[tt2] = o;
                    const int i = itS * 16 + (l & 15), j0 = jt * 16 + 4 * (l >> 4);
                    float sv[4];
#pragma unroll
                    for (int r = 0; r < 4; ++r) sv[r] = (j0 + r <= i) ? s[r] : 0.f;
                    *(LAS u32x2*)(Ss + i * KTS + j0 * 2) = (u32x2){cvt_pk_bf16(sv[0], sv[1]), cvt_pk_bf16(sv[2], sv[3])};
                }
            }
            if (w < 4 && ci + 1 < 68) CS_EW1(ci + 2);
            __syncthreads();
            if (w >= 4 && ci + 1 < 68) CS_EW2(Bn);
            {
                bf16x8 af[2];
#pragma unroll
                for (int ks = 0; ks < 2; ++ks) af[ks] = *(const LAS bf16x8*)(KT + (16 * w + (l & 15)) * KTS + (ks * 32 + 8 * (l >> 4)) * 2);
                f32x4 el;
#pragma unroll
                for (int r = 0; r < 4; ++r) el[r] = elast[16 * w + 4 * (l >> 4) + r];
#pragma unroll
                for (int tt2 = 0; tt2 < 2; ++tt2) {
                    const int it = (w >> 2) + 2 * tt2, vt = w & 3;
                    f32x4 o = oacc[tt2];
#pragma unroll
                    for (int ks = 0; ks < 2; ++ks) {
                        const bf16x8 a = *(const LAS bf16x8*)(Ss + (it * 16 + (l & 15)) * KTS + (ks * 32 + 8 * (l >> 4)) * 2);
                        const bf16x8 bv = *(const LAS bf16x8*)(VT + (vt * 16 + (l & 15)) * KTS + (ks * 32 + 8 * (l >> 4)) * 2);
                        o = __builtin_amdgcn_mfma_f32_16x16x32_bf16(a, bv, o, 0, 0, 0);
                    }
#pragma unroll
                    for (int r = 0; r < 4; ++r) { const int ip = it * 16 + 4 * (l >> 4) + r; const int row = cb + (dir ? 63 - ip : ip);
                        Oout[(size_t)row * D + h * DV + sl * 64 + vt * 16 + (l & 15)] = f2bf(o[r]); }
                }
#pragma unroll
                for (int vt = 0; vt < 4; ++vt) {
                    f32x4 s = st[vt];
#pragma unroll
                    for (int ks = 0; ks < 2; ++ks) { const bf16x8 bv = *(const LAS bf16x8*)(VT + (vt * 16 + (l & 15)) * KTS + (ks * 32 + 8 * (l >> 4)) * 2); s = __builtin_amdgcn_mfma_f32_16x16x32_bf16(af[ks], bv, s, 0, 0, 0); }
                    s = s * el; st[vt] = s;
                    *(LAS u32x2*)(StT + (vt * 16 + (l & 15)) * QS + (16 * w + 4 * (l >> 4)) * 2) = (u32x2){cvt_pk_bf16(s[0], s[1]), cvt_pk_bf16(s[2], s[3])};
                }
            }
            if (w < 4 && ci + 1 < 68) CS_EW2(Bn);
            __syncthreads();
        }
#undef CS_CB
#undef CS_LOAD
#undef CS_EW1
#undef CS_EW2
    }
}
template <bool GLA>
__device__ __forceinline__ void phase_scan_post(const Ctx& c) {
    constexpr int DV = GLA ? 256 : 128, LDP = GLA ? 3328 : 5120, GOFF = GLA ? 2048 : 4096;
    const bf16_t* P = (const bf16_t*)c.big; const bf16_t* OF = (const bf16_t*)c.oacc; const bf16_t* OB = OF + (size_t)MT * D;
    const float* nw = GLA ? c.p->in[22] : c.p->in[26];
    const int l = c.lane, col0 = l * 16;
    float wv[16];
#pragma unroll
    for (int i = 0; i < 16; ++i) wv[i] = nw[(col0 + i) & (DV - 1)];
    for (int row = c.bid * 8 + c.wid; row < MT; row += c.G * 8) {
        const u32x4 f0 = __builtin_nontemporal_load((const u32x4*)(OF + (size_t)row * D + col0)), f1 = __builtin_nontemporal_load((const u32x4*)(OF + (size_t)row * D + col0 + 8));
        const u32x4 b0 = __builtin_nontemporal_load((const u32x4*)(OB + (size_t)row * D + col0)), b1 = __builtin_nontemporal_load((const u32x4*)(OB + (size_t)row * D + col0 + 8));
        const u32x4 g0 = __builtin_nontemporal_load((const u32x4*)(P + (size_t)row * LDP + GOFF + col0)), g1 = __builtin_nontemporal_load((const u32x4*)(P + (size_t)row * LDP + GOFF + col0 + 8));
        const unsigned fw[8] = {f0.x, f0.y, f0.z, f0.w, f1.x, f1.y, f1.z, f1.w}, bw[8] = {b0.x, b0.y, b0.z, b0.w, b1.x, b1.y, b1.z, b1.w}, gw[8] = {g0.x, g0.y, g0.z, g0.w, g1.x, g1.y, g1.z, g1.w};
        float o[16]; float ss = 0.f;
#pragma unroll
        for (int i = 0; i < 8; ++i) { o[2 * i] = bflo(fw[i]) + bflo(bw[i]); o[2 * i + 1] = bfhi(fw[i]) + bfhi(bw[i]); ss += o[2 * i] * o[2 * i] + o[2 * i + 1] * o[2 * i + 1]; }
#pragma unroll
        for (int off = 1; off < DV / 16; off <<= 1) ss += shfl_xor_l(ss, off, l);
        const float rstd = rsqrtf(ss * (1.0f / DV) + 1e-6f);
        unsigned ow[8];
#pragma unroll
        for (int i = 0; i < 8; ++i) { const float y0 = o[2 * i] * rstd * wv[2 * i] * fsilu(bflo(gw[i])), y1 = o[2 * i + 1] * rstd * wv[2 * i + 1] * fsilu(bfhi(gw[i])); ow[i] = cvt_pk_bf16(y0, y1); }
        *(u32x4*)(c.H + (size_t)row * D + col0) = (u32x4){ow[0], ow[1], ow[2], ow[3]};
        *(u32x4*)(c.H + (size_t)row * D + col0 + 8) = (u32x4){ow[4], ow[5], ow[6], ow[7]};
    }
}

constexpr int NSTEP = 12;
constexpr int N_PHASES = 2 + DEPTH * NSTEP;
__device__ __forceinline__ bool phase_valid(int P) {
    if (P == 0 || P == N_PHASES - 1) return true;
    const int layer = (P - 1) / NSTEP, s = (P - 1) % NSTEP, kind = layer % 3;
    if ((s == 7 || s == 8) && kind == 0) return false;
    if (s == 5 && kind == 2) return false;
    return true;
}
#ifndef ENMASK
#define ENMASK 0xffff
#endif
#define EN(bit, stmt) do { if ((ENMASK >> (bit)) & 1) { stmt; } } while (0)
#ifndef FUSE_NORM
#define FUSE_NORM 0
#endif
#ifndef GEMM_ALIGN
#define GEMM_ALIGN true
#endif
#ifndef GEMM_SP2
#define GEMM_SP2 true
#endif
#ifndef DUPMASK
#define DUPMASK 0
#endif
#ifndef DIAG
#define DIAG 0
#endif
#ifndef PLIMIT
#define PLIMIT 1000
#endif
__device__ __forceinline__ bool phase_dup(int P) {
    if (DUPMASK == 0 || P == N_PHASES - 1) return false;
    if (P == 0) return (DUPMASK >> 11) & 1;
    const int layer = (P - 1) / NSTEP, s = (P - 1) % NSTEP, kind = layer % 3; int bit = -1;
    if (s == 0 && layer > 0) bit = 12; else if (s == 2 || s == 11) bit = 8; else if (s == 8) bit = 10; else if (s == 1 || s == 10) bit = 1; else if (s == 3 || s == 9) bit = 2; else if (s == 4) bit = kind == 0 ? 3 : 6; else if (s == 5) bit = kind == 0 ? 7 : -1; else if (s == 6 && kind != 0) bit = (kind == 1 ? 4 : 5); else if (s == 7 && kind != 0) bit = 7;
    return bit >= 0 && ((DUPMASK >> bit) & 1);
}
enum { G_NONE = 0, G_SWIGLU, G_RESID, G_PLAIN, G_GLU };

__global__ void __launch_bounds__(NTHR, 2) fwd_kernel(Params prm) {
    extern __shared__ __attribute__((aligned(16))) unsigned char lds_raw[];
#if COOP
    { LAS unsigned* stz = (LAS unsigned*)((LAS unsigned char*)lds_raw + LDS_MAIN); if (threadIdx.x < 4) stz[threadIdx.x] = 0u; }
    __syncthreads();
    bool first_seam = true;
    XcdBarrier xbar = xcd_barrier_post((unsigned*)(prm.ws + WS_BAR), (volatile LAS unsigned*)((LAS unsigned char*)lds_raw + LDS_MAIN));
#endif
    for (int Pi = prm.ph_lo * 2; Pi < prm.ph_hi * 2; ++Pi) {
        const int P = Pi >> 1;
        if ((Pi & 1) && !phase_dup(P)) continue;
        if (!phase_valid(P)) continue;
        if (P >= PLIMIT && P != N_PHASES - 1) continue;
        Ctx c;
        { int tid = threadIdx.x; asm volatile("" : "+v"(tid)); unsigned char* ws = prm.ws; asm volatile("" : "+s"(ws)); float* outp = prm.out; asm volatile("" : "+s"(outp));
          c.p = &prm; c.lds = (LAS unsigned char*)lds_raw; c.tid = tid; c.lane = tid & 63; c.wid = __builtin_amdgcn_readfirstlane(tid >> 6); { int gg = gridDim.x, bb = blockIdx.x; asm volatile("" : "+s"(gg), "+s"(bb)); c.G = gg; c.bid = bb; }
          c.X = (_Float16*)(ws + WS_X16); c.outp = outp; c.mod = (float*)(ws + WS_MOD); c.lb = (float*)(ws + WS_LB); c.H = (bf16_t*)(ws + WS_H); c.big = ws + WS_BIG; c.oacc = ws + WS_OACC; }
        unsigned char* const wsb = c.big - WS_BIG;
        bf16_t* const WFI = (bf16_t*)(wsb + WS_WFI); bf16_t* const WFO = (bf16_t*)(wsb + WS_WFO);
        int gt = G_NONE; const bf16_t* gA = nullptr; const bf16_t* gB = nullptr; int gN = 0, gK = 0, gM = MT;
        bf16_t* eO = nullptr; int eld = 0, emode = 0; int fz = 0, fseam = 0, fhperm = 0, fnl = 0, fns = 0; const float* emod = nullptr; float ecoef = 1.f; int eperm = 0, eskip = 0; const float* ebias = nullptr;
        if (P == 0) { EN(0, phase_prep(c)); }
        else if (P == N_PHASES - 1) {
#if DIAG == 0
            EN(1, phase_final(c));
#elif DIAG == 1
            { const bf16_t* OF = (const bf16_t*)c.oacc; const bf16_t* OB = OF + (size_t)MT * D; for (size_t e = (size_t)c.bid * NTHR + c.tid; e < (size_t)ML * D; e += (size_t)c.G * NTHR) prm.out[e] = bf2f(OF[e]) + bf2f(OB[e]); }
#elif DIAG == 2
            { const bf16_t* Pp = (const bf16_t*)c.big; for (size_t e = (size_t)c.bid * NTHR + c.tid; e < (size_t)ML * D; e += (size_t)c.G * NTHR) prm.out[e] = bf2f(Pp[(e >> 10) * 3328 + (e & 1023)]); }
#elif DIAG == 3
            { for (size_t e = (size_t)c.bid * NTHR + c.tid; e < (size_t)ML * D; e += (size_t)c.G * NTHR) prm.out[e] = bf2f(c.H[e]); }
#endif
        }
        else {
            const int layer = (P - 1) / NSTEP, s = (P - 1) % NSTEP, kind = layer % 3, j = layer / 3; const bool last = layer == DEPTH - 1;
            const float* modl = c.mod + (size_t)layer * 9 * 9216;
            switch (s) {
            case 0: EN(2, phase_norm(c, layer, 0, layer == 0, false, (layer > 0 && c.G == 256) ? 7 : 0, MT, (FUSE_NORM && c.G == 256 && layer > 0) ? ML : 0)); if (layer > 0) { EN(3, conv_ffn(c, layer)); } break;
            case 1: case 10: { const int sub = s == 1 ? 0 : 1; if (last && sub) gM = ML; gt = G_SWIGLU; gA = c.H; gB = WFI + (size_t)sub * 2 * DFF * D; gN = 2 * DFF; gK = D; eO = (bf16_t*)c.big; eld = DFF; } break;
            case 2: case 11: { const int sub = s == 2 ? 0 : 1; gt = G_RESID; gA = (const bf16_t*)c.big; gB = WFO + (size_t)sub * D * DFF; gN = D; gK = DFF; emod = modl + (sub ? 8 : 2) * 1024; ecoef = 0.5f; eskip = (last && sub) ? 1 : 0;
                if (FUSE_NORM && c.G == 256) { if (!sub) { fz = 1; fseam = layer * 3; fnl = layer; fns = 1; fhperm = kind == 1; }
                    else if (!last) { fz = 1; fseam = layer * 3 + 2; fnl = layer + 1; fns = 0; } } } break;
            case 3: EN(2, phase_norm(c, layer, 1, false, kind == 1, c.G == 256 ? 7 : 0, MT, (FUSE_NORM && c.G == 256) ? ML : 0)); break;
            case 4:
                if (kind == 0) { EN(4, phase_s5_scan(c, j)); }
                else if (kind == 1) { gt = G_PLAIN; gA = c.H; gB = (const bf16_t*)(wsb + WS_WGI); gN = 3328; gK = D; eO = (bf16_t*)c.big; eld = 3328; }
                else { gt = G_PLAIN; gA = c.H; gB = (const bf16_t*)(wsb + WS_WHI); gN = 5120; gK = D; eO = (bf16_t*)c.big; eld = 5120; emode = 1; }
                break;
            case 5:
                if (kind == 0) { EN(5, phase_s5_post(c, j)); } else if (kind == 1) { EN(8, phase_scan_pre<true>(c)); }
                break;
            case 6:
                if (kind == 0) { if (last) gM = ML; gt = G_GLU; gA = (const bf16_t*)c.oacc; gB = (const bf16_t*)(wsb + WS_WGLU) + (size_t)j * 2 * D * D; gN = 2 * D; gK = D; emod = modl + 5 * 1024; ebias = prm.in[18] + (size_t)j * 2 * D; eskip = last ? 1 : 0; }
                else if (kind == 1) { EN(6, phase_chunk_scan<true>(c)); } else { EN(7, phase_chunk_scan<false>(c)); }
                break;
            case 7:
                if (kind == 1) { EN(8, phase_scan_post<true>(c)); } else { EN(8, phase_scan_post<false>(c)); }
                break;
            case 8: { gt = G_RESID; gA = c.H; gB = (const bf16_t*)(wsb + (kind == 1 ? WS_WGO : WS_WHO)); gN = D; gK = D; emod = modl + 5 * 1024; ecoef = 1.0f; eperm = kind == 1; eskip = last ? 1 : 0;
                if (FUSE_NORM && c.G == 256 && kind == 2) { fz = 1; fseam = layer * 3 + 1; fnl = layer; fns = 2; } } break;
            case 9: EN(2, phase_norm(c, layer, 2, false, false, (kind == 0 || c.G != 256) ? 0 : 4, last ? ML : MT, (FUSE_NORM && c.G == 256 && kind == 2) ? ML : 0)); break;
            }
        }
        if (gt != G_NONE) {
            pg8::Gemm g{gA, gB, gM, gN, gK}; pg8::StaticOrder S; S.init(gM, gN, c.G, c.bid, gK / 64);
            if (Pi & 1) ecoef = 0.f;
            if (gt == G_SWIGLU) { pg8::EpiSwiGLU E{eO, eld}; EN(9, (pg8::gemm_phase<pg8::EpiSwiGLU, pg8::StaticOrder, GEMM_ALIGN, GEMM_SP2>(c.lds, g, S, E))); }
            else if (gt == G_RESID) { pg8::SplitOrder SS; SS.init(ML, MT, gN, c.G, c.bid, gK / 64, gK == DFF ? 7 : 4, eskip); pg8::EpiResid E{c.X, wsb, emod, ecoef, eperm, eskip}; EN(10, (pg8::gemm_phase<pg8::EpiResid, pg8::SplitOrder, GEMM_ALIGN, GEMM_SP2>(c.lds, g, SS, E))); }
            else if (gt == G_PLAIN) { pg8::EpiPlain E{eO, eld, emode, c.lb}; EN(11, (pg8::gemm_phase<pg8::EpiPlain, pg8::StaticOrder, GEMM_ALIGN, GEMM_SP2>(c.lds, g, S, E))); }
            else { pg8::EpiGLU E{c.X, emod, ebias, eskip}; EN(12, (pg8::gemm_phase<pg8::EpiGLU, pg8::StaticOrder, GEMM_ALIGN, GEMM_SP2>(c.lds, g, S, E))); }
        }
        if (Pi + 1 < prm.ph_hi * 2) {
#if COOP
            if (first_seam) { cg::this_grid().sync(); first_seam = false; }
            else xcd_barrier(xbar);
            if (DUPMASK & 1) xcd_barrier(xbar);
#endif
        }
    }
}

extern "C" void kernel_launch(void* const* d_in, const int* in_sizes, int n_in, void* d_out, int out_size, void* d_ws, size_t ws_size, hipStream_t stream) {
    static int grid = 0;
    if (grid == 0) {
        if (n_in != 29 || ws_size < WS_END) { fprintf(stderr, "kernel_launch: need 29 inputs and %zu bytes of workspace; got %d, %zu\n", (size_t)WS_END, n_in, ws_size); grid = -1; return; }
        int dev = 0, cus = 0, per_cu = 0;
        hipGetDevice(&dev); hipDeviceGetAttribute(&cus, hipDeviceAttributeMultiprocessorCount, dev);
        if (hipFuncSetAttribute((const void*)fwd_kernel, hipFuncAttributeMaxDynamicSharedMemorySize, LDS_BYTES) != hipSuccess) { fprintf(stderr, "kernel_launch: hipFuncSetAttribute failed\n"); grid = -1; return; }
        if (hipOccupancyMaxActiveBlocksPerMultiprocessor(&per_cu, (const void*)fwd_kernel, NTHR, LDS_BYTES) != hipSuccess || per_cu < 1) { fprintf(stderr, "kernel_launch: occupancy query says %d\n", per_cu); per_cu = 1; }
        (void)hipGetLastError();
        grid = cus;
    }
    if (grid < 0) return;
    Params p{};
#if COOP
    if (hipMemsetAsync((char*)d_ws + WS_BAR, 0, WS_ZERO_BYTES, stream) != hipSuccess) { fprintf(stderr, "kernel_launch: memset of the barrier words failed\n"); return; }
#endif
    for (int i = 0; i < 29; ++i) p.in[i] = (const float*)d_in[i];
    p.out = (float*)d_out; p.ws = (unsigned char*)d_ws;
#if COOP
    p.ph_lo = 0; p.ph_hi = N_PHASES;
    void* args[] = {&p};
    hipError_t e = hipLaunchCooperativeKernel((const void*)fwd_kernel, dim3(grid), dim3(NTHR), args, LDS_BYTES, stream);
    if (e != hipSuccess) fprintf(stderr, "cooperative launch failed: %s (grid %d)\n", hipGetErrorString(e), grid);
#else
    for (int P = 0; P < N_PHASES; ++P) {
        const int layer = (P - 1) / NSTEP, s = (P - 1) % NSTEP;
        if (P != 0 && P != N_PHASES - 1 && (((s == 7 || s == 8) && layer % 3 == 0) || (s == 5 && layer % 3 == 2))) continue;
        if (P >= PLIMIT && P != N_PHASES - 1) continue;
        p.ph_lo = P; p.ph_hi = P + 1;
        hipLaunchKernelGGL(fwd_kernel, dim3(grid), dim3(NTHR), LDS_BYTES, stream, p);
    }
#endif
}
```

```cpp
#include <hip/hip_runtime.h>
#include <hip/hip_cooperative_groups.h>
#include <cstdio>
namespace cg = cooperative_groups;

#ifndef COOP
#define COOP 1
#endif

#define LAS __attribute__((address_space(3)))
typedef unsigned short bf16_t;
typedef short bf16x8 __attribute__((ext_vector_type(8)));
typedef float f32x4 __attribute__((ext_vector_type(4)));
typedef float f32x16 __attribute__((ext_vector_type(16)));
typedef unsigned u32x4 __attribute__((ext_vector_type(4)));
typedef unsigned u32x2 __attribute__((ext_vector_type(2)));

constexpr int D = 1024, NB = 8, SEQ = 4096, CTXL = 256, ML = NB * SEQ, MC = NB * CTXL, MT = ML + MC, DFF = 2816, DEPTH = 4;
constexpr int NTHR = 512;
constexpr int LDS_MAIN = 157696;
constexpr int LDS_BYTES = LDS_MAIN + 16;

constexpr size_t WS_XC    = 0;
constexpr size_t WS_MOD   = WS_XC + (size_t)MC * D * 4;
constexpr size_t WS_LB    = WS_MOD + (size_t)4 * 9 * 9216 * 4;
constexpr size_t WS_WFI   = WS_LB + 8192;
constexpr size_t WS_WFO   = WS_WFI + (size_t)2 * 5632 * 1024 * 2;
constexpr size_t WS_WGLU  = WS_WFO + (size_t)2 * 1024 * 2816 * 2;
constexpr size_t WS_WGI   = WS_WGLU + (size_t)2 * 2048 * 1024 * 2;
constexpr size_t WS_WGO   = WS_WGI + (size_t)3328 * 1024 * 2;
constexpr size_t WS_WHI   = WS_WGO + (size_t)1024 * 1024 * 2;
constexpr size_t WS_WHO   = WS_WHI + (size_t)5120 * 1024 * 2;
constexpr size_t WS_H     = WS_WHO + (size_t)1024 * 1024 * 2;
constexpr size_t WS_BIG   = WS_H + (size_t)MT * D * 2;
constexpr size_t WS_OACC  = WS_BIG + (size_t)MT * 5120 * 2;
constexpr size_t WS_BAR   = WS_OACC + (size_t)MT * D * 4;
constexpr size_t WS_CNT   = WS_BAR + 16384;
constexpr size_t WS_ZERO_BYTES = 16384 + (size_t)12 * 128 * 256;
constexpr size_t WS_SLOT  = WS_BAR + WS_ZERO_BYTES;
constexpr size_t WS_X16   = WS_SLOT + (size_t)12 * ML * 4 * 4;
constexpr size_t WS_END   = WS_X16 + (size_t)MT * D * 2;

typedef __bf16 bf16v2_t __attribute__((ext_vector_type(2)));
typedef float f32v2_t __attribute__((ext_vector_type(2)));
__device__ __forceinline__ unsigned cvt_pk_bf16(float lo, float hi) { f32v2_t v = {lo, hi}; bf16v2_t b = __builtin_convertvector(v, bf16v2_t); return __builtin_bit_cast(unsigned, b); }
__device__ __forceinline__ bf16_t f2bf(float f) { return __builtin_bit_cast(unsigned short, (__bf16)f); }
__device__ __forceinline__ float bf2f(bf16_t b) { return __uint_as_float(((unsigned)b) << 16); }
typedef _Float16 f16v2_t __attribute__((ext_vector_type(2)));
__device__ __forceinline__ unsigned pack_h2(float a, float b) { f16v2_t h = {(_Float16)a, (_Float16)b}; return __builtin_bit_cast(unsigned, h); }
__device__ __forceinline__ float h2lo(unsigned w) { return (float)__builtin_bit_cast(f16v2_t, w).x; }
__device__ __forceinline__ float h2hi(unsigned w) { return (float)__builtin_bit_cast(f16v2_t, w).y; }
__device__ __forceinline__ f32x4 ld_h4(const void* p) { const u32x2 w = *(const u32x2*)p; return (f32x4){h2lo(w.x), h2hi(w.x), h2lo(w.y), h2hi(w.y)}; }
__device__ __forceinline__ void st_h4(void* p, f32x4 v) { u32x2 w; w.x = pack_h2(v[0], v[1]); w.y = pack_h2(v[2], v[3]); *(u32x2*)p = w; }
__device__ __forceinline__ void ld_h8(const void* p, f32x4& lo, f32x4& hi) { const u32x4 w = *(const u32x4*)p; lo = (f32x4){h2lo(w.x), h2hi(w.x), h2lo(w.y), h2hi(w.y)}; hi = (f32x4){h2lo(w.z), h2hi(w.z), h2lo(w.w), h2hi(w.w)}; }
__device__ __forceinline__ void st_h8(void* p, f32x4 lo, f32x4 hi) { u32x4 w; w.x = pack_h2(lo[0], lo[1]); w.y = pack_h2(lo[2], lo[3]); w.z = pack_h2(hi[0], hi[1]); w.w = pack_h2(hi[2], hi[3]); *(u32x4*)p = w; }
__device__ __forceinline__ float bflo(unsigned w) { return __uint_as_float(w << 16); }
__device__ __forceinline__ float bfhi(unsigned w) { return __uint_as_float(w & 0xffff0000u); }
__device__ __forceinline__ float fsigmoid(float x) { return __builtin_amdgcn_rcpf(1.0f + __expf(-x)); }
__device__ __forceinline__ float fsilu(float x) { return x * fsigmoid(x); }
__device__ __forceinline__ float shfl_xor_l(float v, int mask, int lane) { return __int_as_float(__builtin_amdgcn_ds_bpermute((lane ^ mask) << 2, __float_as_int(v))); }
__device__ __forceinline__ int permrow(int row) { return (row & ~4095) | ((row & 63) << 6) | ((row >> 6) & 63); }

#define GAS1 __attribute__((address_space(1)))
#define GIN(p) ((const float*)(const GAS1 float*)(p))
struct Params {
    const float* in[29];
    float* out;
    unsigned char* ws;
    int ph_lo, ph_hi;
};


#define XB_TMO      128
#define XB_XCNT(j)  (256  + 64 * (j))
#define XB_XSUB(j)  (1280 + 64 * (j))
#define XB_XGEN(j)  (2304 + 64 * (j))
#define XB_TOP      3328
#define XB_TOPGEN   3392
#define XCD_BAR_WORDS 3456
#define XB_SPIN_CAP (1u << 18)

__device__ __forceinline__ unsigned xb_ld(unsigned* p)              { return __hip_atomic_load(p, __ATOMIC_RELAXED, __HIP_MEMORY_SCOPE_AGENT); }
__device__ __forceinline__ unsigned xb_add(unsigned* p, unsigned v) { return __hip_atomic_fetch_add(p, v, __ATOMIC_RELAXED, __HIP_MEMORY_SCOPE_AGENT); }
__device__ __forceinline__ unsigned xb_xcc_id() { return (unsigned)__builtin_amdgcn_s_getreg((3 << 11) | 20) & 0xFu; }
#define XB_SPIN(cond, bar) do { unsigned _sp = 0; while (cond) { __builtin_amdgcn_s_sleep(1); \
    if ((++_sp & 255u) == 0u) { if (xb_ld(&(bar)[XB_TMO])) break; if (_sp > XB_SPIN_CAP) { atomicAdd(&(bar)[XB_TMO], 1u); break; } } } } while (0)

struct XcdBarrier {
    unsigned* bar; unsigned x;
    volatile LAS unsigned* st;
};

__device__ __forceinline__ XcdBarrier xcd_barrier_post(unsigned* bar, volatile LAS unsigned* st) {
    XcdBarrier b; b.bar = bar; b.x = xb_xcc_id(); b.st = st;
    if (threadIdx.x == 0) (void)xb_add(&bar[XB_XCNT(b.x)], 1u);
    return b;
}
__device__ __forceinline__ void xcd_barrier_complete(unsigned* bar, unsigned x, unsigned& nloc, unsigned& nx) {
    const unsigned G = gridDim.x * gridDim.y * gridDim.z;
    unsigned sum, cnt, mine, sp = 0u;
    for (;;) {
        sum = 0u; cnt = 0u; mine = 0u;
#pragma unroll
        for (unsigned j = 0; j < 16; ++j) { const unsigned c = xb_ld(&bar[XB_XCNT(j)]); sum += c; cnt += (c > 0u) ? 1u : 0u; mine = (j == x) ? c : mine; }
        if (sum == G) break;
        __builtin_amdgcn_s_sleep(1);
        if ((++sp & 255u) == 0u) { if (xb_ld(&bar[XB_TMO])) break; if (sp > XB_SPIN_CAP) { atomicAdd(&bar[XB_TMO], 1u); break; } }
    }
    nloc = mine > 0u ? mine : 1u; nx = cnt > 0u ? cnt : 1u;
}

__device__ __forceinline__ void xcd_barrier(const XcdBarrier& b) {
    asm volatile("s_waitcnt vmcnt(0)" ::: "memory");
    __syncthreads();
    if (threadIdx.x == 0) {
        unsigned* bar = b.bar;
        __builtin_amdgcn_s_waitcnt(0);
        unsigned nloc = b.st[0], nx = b.st[1];
        if (nloc == 0u) { xcd_barrier_complete(bar, b.x, nloc, nx); b.st[0] = nloc; b.st[1] = nx; }
        const unsigned old = xb_add(&bar[XB_XSUB(b.x)], 1u);
        const unsigned gen = old / nloc;
        if (old + 1u == (gen + 1u) * nloc) {
            __builtin_amdgcn_fence(__ATOMIC_RELEASE, "agent");
            asm volatile("s_waitcnt vmcnt(0)" ::: "memory");
            const unsigned og = xb_add(&bar[XB_TOP], 1u);
            const unsigned tg = og / nx;
            if (og + 1u == (tg + 1u) * nx) xb_add(&bar[XB_TOPGEN], 1u);
            else XB_SPIN(xb_ld(&bar[XB_TOPGEN]) == tg, bar);
            __builtin_amdgcn_fence(__ATOMIC_ACQUIRE, "agent");
            xb_add(&bar[XB_XGEN(b.x)], 1u);
            asm volatile("s_waitcnt vmcnt(0)" ::: "memory");
        } else {
            XB_SPIN(xb_ld(&bar[XB_XGEN(b.x)]) == gen, bar);
            __builtin_amdgcn_fence(__ATOMIC_ACQUIRE, "agent");
            asm volatile("s_waitcnt vmcnt(0)" ::: "memory");
        }
    }
    __syncthreads();
}
namespace pg8 {
#define PG8_LAS __attribute__((address_space(3)))
typedef unsigned short bf16_t;
typedef short bf16x8 __attribute__((ext_vector_type(8)));
typedef float f32x4 __attribute__((ext_vector_type(4)));
typedef unsigned u32x4 __attribute__((ext_vector_type(4)));
constexpr int BM = 256, BK = 64, HALF = 128, HTB = HALF * BK * 2  , STAGE_BYTES = 8 * HTB, NXCD = 8, WGM = 8;

__host__ __device__ __forceinline__ int lds_byte(int r, int c) { const int st = (r >> 4) * 2 + (c >> 5), rr = r & 15, cc = c & 31, ob = rr * 64 + cc * 2; return st * 1024 + (ob ^ (((ob >> 9) & 1) << 5)); }
__host__ __device__ __forceinline__ void stage_rc(int b, int& R, int& C) { const int st = b / 1024, sb = b % 1024, swz = sb ^ (((sb >> 9) & 1) << 5); R = (st >> 1) * 16 + swz / 64; C = (st & 1) * 32 + (swz % 64) / 2; }
__host__ __device__ __forceinline__ int perm32(int rho) { const int n = rho >> 4, i = rho & 15; return 8 * (i >> 2) + 4 * n + (i & 3); }

struct Unit { int pm, pn, k0, nt, sp; };
struct Gemm { const bf16_t* A; const bf16_t* Bt; int M, N, K; };

struct StaticOrder {
    int nM, nN, nwg, G, c, ntk;
    __host__ __device__ void init(int M, int N, int G_, int c_, int ntk_) { nM = M / BM; nN = N / BM; nwg = nM * nN; G = G_; c = c_; ntk = ntk_; }
    __host__ __device__ bool next(int i, Unit& u) const {
        const long L = (long)i * G + c; if (L >= nwg) return false;
        int wgid = (int)L; { const int q = nwg / NXCD, r = nwg % NXCD, xcd = wgid % NXCD, off = wgid / NXCD; wgid = (xcd < r ? xcd * (q + 1) : r * (q + 1) + (xcd - r) * q) + off; }
        const int nig = WGM * nN, gid = wgid / nig, fm = gid * WGM, gsz = (nM - fm) < WGM ? (nM - fm) : WGM;
        u.pm = fm + ((wgid % nig) % gsz); u.pn = (wgid % nig) / gsz; u.k0 = 0; u.nt = ntk; u.sp = -1; return true;
    }
    __device__ __forceinline__ void a_ready(const Unit&) const {}
    __device__ __forceinline__ void done(const Unit&) const {}
};

struct SplitOrder {
    StaticOrder lat, all; int nsplit, skip_ctx, ntk, G, c;
    __host__ __device__ void init(int Mlat, int Mall, int N, int G_, int c_, int ntk_, int nsplit_, int skip_) { lat.init(Mlat, N, G_, c_, ntk_); all.init(Mall, N, G_, c_, ntk_); nsplit = nsplit_; skip_ctx = skip_; ntk = ntk_; G = G_; c = c_; }
    __host__ __device__ bool next(int i, Unit& u) const {
        if (G != 256 || lat.nN != 4) return all.next(i, u);
        if (i < 2) return lat.next(i, u);
        if (i > 2 || skip_ctx || c >= 32 * nsplit) return false;
        const int cu = c / nsplit, s = c % nsplit, bs = (ntk / nsplit) & ~1;
        u.pm = lat.nM + (cu >> 2); u.pn = cu & 3; u.k0 = s * bs; u.nt = (s == nsplit - 1) ? ntk - s * bs : bs; u.sp = s; return true;
    }
    __device__ __forceinline__ void a_ready(const Unit&) const {}
    __device__ __forceinline__ void done(const Unit&) const {}
};

struct EpiSwiGLU {
    static constexpr bool PERM = true, AFTER_DRAIN = false;
    bf16_t* O; int ldc;
    __device__ __forceinline__ void operator()(const f32x4 (&acc)[2][2][4][2], const Unit& u, int wr, int wc, int fr, int fq) const {
        const int row0 = u.pm * BM + wr * 64 + fr, col0 = u.pn * 128 + wc * 32 + 8 * fq;
#pragma unroll
        for (int ai = 0; ai < 2; ++ai)
#pragma unroll
            for (int m = 0; m < 4; ++m) {
                bf16_t* rowp = O + (size_t)(row0 + ai * HALF + m * 16) * ldc + col0;
                float v[8];
#pragma unroll
                for (int n = 0; n < 2; ++n)
#pragma unroll
                    for (int i = 0; i < 4; ++i) { const float g = acc[ai][0][m][n][i], uu = acc[ai][1][m][n][i]; v[n * 4 + i] = ::fsilu(g) * uu; }
                u32x4 w; w.x = ::cvt_pk_bf16(v[0], v[1]); w.y = ::cvt_pk_bf16(v[2], v[3]); w.z = ::cvt_pk_bf16(v[4], v[5]); w.w = ::cvt_pk_bf16(v[6], v[7]);
                *(u32x4*)rowp = w;
            }
    }
};
struct EpiPlain {
    static constexpr bool PERM = true, AFTER_DRAIN = false;
    bf16_t* O; int ldc; int mode; const float* lb;
    __device__ __forceinline__ void operator()(const f32x4 (&acc)[2][2][4][2], const Unit& u, int wr, int wc, int fr, int fq) const {
        const int row0 = u.pm * BM + wr * 64 + fr, col0 = u.pn * BM + wc * 32 + 8 * fq;
        const int tr = (mode == 1) ? ((u.pn < 4) ? 1 : ((u.pn >= 8 && u.pn < 16) ? 2 : 0)) : 0;
        f32x4 lbv[2][2];
        if (tr == 2) {
#pragma unroll
            for (int bj = 0; bj < 2; ++bj)
#pragma unroll
                for (int n = 0; n < 2; ++n) lbv[bj][n] = *(const f32x4*)(lb + (col0 - 2048) + bj * HALF + 4 * n);
        }
#pragma unroll
        for (int ai = 0; ai < 2; ++ai)
#pragma unroll
            for (int m = 0; m < 4; ++m) {
                bf16_t* rowp = O + (size_t)(row0 + ai * HALF + m * 16) * ldc + col0;
#pragma unroll
                for (int bj = 0; bj < 2; ++bj) {
                    f32x4 v0 = acc[ai][bj][m][0], v1 = acc[ai][bj][m][1];
                    u32x4 w;
                    if (tr == 2) {
#pragma unroll
                        for (int i = 0; i < 4; ++i) {
                            const float s0 = ::fsigmoid(fminf(fmaxf(v0[i], -30.f), 30.f)), s1 = ::fsigmoid(fminf(fmaxf(v1[i], -30.f), 30.f));
                            v0[i] = __logf(lbv[bj][0][i] + (1.0f - lbv[bj][0][i]) * s0); v1[i] = __logf(lbv[bj][1][i] + (1.0f - lbv[bj][1][i]) * s1);
                        }
                        w.x = ::pack_h2(v0[0], v0[1]); w.y = ::pack_h2(v0[2], v0[3]); w.z = ::pack_h2(v1[0], v1[1]); w.w = ::pack_h2(v1[2], v1[3]);
                    } else {
                        if (tr == 1) {
#pragma unroll
                            for (int i = 0; i < 4; ++i) { v0[i] = ::fsilu(v0[i]); v1[i] = ::fsilu(v1[i]); }
                        }
                        w.x = ::cvt_pk_bf16(v0[0], v0[1]); w.y = ::cvt_pk_bf16(v0[2], v0[3]); w.z = ::cvt_pk_bf16(v1[0], v1[1]); w.w = ::cvt_pk_bf16(v1[2], v1[3]);
                    }
                    *(u32x4*)(rowp + bj * HALF) = w;
                }
            }
    }
};
struct EpiResid {
    static constexpr bool PERM = true, AFTER_DRAIN = false;
    _Float16* X; unsigned char* wsb; const float* modg; float coef; int permute; int skip_ctx;
    __device__ __forceinline__ void operator()(const f32x4 (&acc)[2][2][4][2], const Unit& u, int wr, int wc, int fr, int fq) const {
        const int base = u.pm * BM; const bool is_ctx = base >= ::ML; const int b = is_ctx ? 8 : (base >> 12);
        if (is_ctx && skip_ctx) return;
        const int col0 = u.pn * BM + wc * 32 + 8 * fq;
        const float* gp = modg + (size_t)b * 9216 + col0;
        f32x4 g0[2], g1[2];
#pragma unroll
        for (int bj = 0; bj < 2; ++bj) { g0[bj] = *(const f32x4*)(gp + bj * HALF) * coef; g1[bj] = *(const f32x4*)(gp + bj * HALF + 4) * coef; }
        if (u.sp >= 0) {
#pragma unroll
            for (int ai = 0; ai < 2; ++ai)
#pragma unroll
                for (int m = 0; m < 4; ++m) {
                    const int row = base + ai * HALF + wr * 64 + m * 16 + fr;
                    _Float16* pp = (_Float16*)(wsb + ::WS_OACC) + ((size_t)u.sp * ::MC + (row - ::ML)) * ::D + col0;
#pragma unroll
                    for (int bj = 0; bj < 2; ++bj) ::st_h8(pp + bj * HALF, g0[bj] * acc[ai][bj][m][0], g1[bj] * acc[ai][bj][m][1]);
                }
            return;
        }
#pragma unroll
        for (int ai = 0; ai < 2; ++ai)
#pragma unroll
            for (int m = 0; m < 4; ++m) {
                const int row = base + ai * HALF + wr * 64 + m * 16 + fr;
                _Float16* xp = X + (size_t)((permute && !is_ctx) ? ::permrow(row) : row) * ::D + col0;
#pragma unroll
                for (int bj = 0; bj < 2; ++bj) { f32x4 lo, hi; ::ld_h8(xp + bj * HALF, lo, hi); ::st_h8(xp + bj * HALF, lo + g0[bj] * acc[ai][bj][m][0], hi + g1[bj] * acc[ai][bj][m][1]); }
                if (m & 1) asm volatile("" ::: "memory");
            }
    }
};
struct EpiGLU {
    static constexpr bool PERM = true, AFTER_DRAIN = false;
    _Float16* X; const float* modg; const float* bias; int skip_ctx;
    __device__ __forceinline__ void operator()(const f32x4 (&acc)[2][2][4][2], const Unit& u, int wr, int wc, int fr, int fq) const {
        const int base = u.pm * BM; const bool is_ctx = base >= ::ML; const int b = is_ctx ? 8 : (base >> 12);
        if (is_ctx && skip_ctx) return;
        const int col0 = u.pn * 128 + wc * 32 + 8 * fq;
        const float* gp = modg + (size_t)b * 9216 + col0;
        f32x4 gv[2], bv[2], bg[2];
#pragma unroll
        for (int n = 0; n < 2; ++n) { gv[n] = *(const f32x4*)(gp + 4 * n); bv[n] = *(const f32x4*)(bias + col0 + 4 * n); bg[n] = *(const f32x4*)(bias + ::D + col0 + 4 * n); }
#pragma unroll
        for (int ai = 0; ai < 2; ++ai)
#pragma unroll
            for (int m = 0; m < 4; ++m) {
                const int row = base + ai * HALF + wr * 64 + m * 16 + fr;
                _Float16* xp = X + (size_t)row * ::D + col0;
                f32x4 y[2];
#pragma unroll
                for (int n = 0; n < 2; ++n) {
                    const f32x4 val = acc[ai][0][m][n] + bv[n], gt = acc[ai][1][m][n] + bg[n];
#pragma unroll
                    for (int i = 0; i < 4; ++i) y[n][i] = val[i] * ::fsigmoid(gt[i]);
                }
                f32x4 lo, hi; ::ld_h8(xp, lo, hi); ::st_h8(xp, lo + gv[0] * y[0], hi + gv[1] * y[1]);
            }
    }
};
template <class Epi, class Sched, bool ALIGN_EPI = false, bool SP2 = false>
__device__ __forceinline__ void gemm_phase(PG8_LAS unsigned char* lds, const Gemm g, const Sched& S, const Epi& E) {
    int tid_l = threadIdx.x; asm volatile("" : "+v"(tid_l)); const int tid = tid_l, wid = __builtin_amdgcn_readfirstlane(tid >> 6), lane = tid & 63, wr = wid >> 2, wc = wid & 3, fr = lane & 15, fq = lane >> 4;
    const int K = g.K;
    unsigned voffA[2], voffB[2];
#pragma unroll
    for (int i = 0; i < 2; ++i) { int R, C; stage_rc(tid * 16 + i * 8192, R, C); const int Rb = Epi::PERM ? ((R & ~31) + perm32(R & 31)) : R;
        voffA[i] = (unsigned)(R * K + C) * 2u; voffB[i] = (unsigned)(Rb * K + C) * 2u; }
    const size_t kstep = (size_t)(BK * 2);
    const size_t hstep = (size_t)HALF * K * 2;
    const size_t tstep = 2 * hstep;
    const unsigned ldsw = (unsigned)wid * 1024u;
    const int aoff = lds_byte(wr * 64 + fr, fq * 8), boff = lds_byte(wc * 32 + fr, fq * 8);
#define PG8_SA(b, h) (((b) * 2 + (h)) * HTB)
#define PG8_SB(b, h) ((4 + (b) * 2 + (h)) * HTB)
#define PG8_STAGE(bufoff, gbase, voff) do { _Pragma("unroll") for (int _i = 0; _i < 2; ++_i) \
        __builtin_amdgcn_global_load_lds((const unsigned*)((const char*)(gbase) + (voff)[_i]), (PG8_LAS unsigned*)(lds + (bufoff) + ldsw + _i * 8192), 16, 0, 0); } while (0)
#define PG8_LDA(dst, b, h) do { _Pragma("unroll") for (int m = 0; m < 4; ++m) _Pragma("unroll") for (int k = 0; k < 2; ++k) dst[m][k] = *(const PG8_LAS bf16x8*)(lds + PG8_SA(b, h) + aoff + m * 2048 + k * 1024); } while (0)
#define PG8_LDB(dst, b, h) do { _Pragma("unroll") for (int n = 0; n < 2; ++n) _Pragma("unroll") for (int k = 0; k < 2; ++k) dst[n][k] = *(const PG8_LAS bf16x8*)(lds + PG8_SB(b, h) + boff + n * 2048 + k * 1024); } while (0)
#define PG8_MMA(ai, bj, At, Bt) do { __builtin_amdgcn_s_setprio(1); _Pragma("unroll") for (int m = 0; m < 4; ++m) _Pragma("unroll") for (int n = 0; n < 2; ++n) _Pragma("unroll") for (int k = 0; k < 2; ++k) \
        acc[ai][bj][m][n] = __builtin_amdgcn_mfma_f32_16x16x32_bf16(Bt[n][k], At[m][k], acc[ai][bj][m][n], 0, 0, 0); __builtin_amdgcn_s_setprio(0); } while (0)
#define PG8_WAIT_V(n) asm volatile("s_waitcnt vmcnt(" #n ")" ::: "memory")
#define PG8_WAIT_L(n) asm volatile("s_waitcnt lgkmcnt(" #n ")" ::: "memory")
#define PG8_BAR __builtin_amdgcn_s_barrier()
#define PG8_SCHED __builtin_amdgcn_sched_barrier(0)
    Unit cur, nxt; int ui = 0;
    if (!S.next(0, cur)) return;
    f32x4 acc[2][2][4][2];
#pragma unroll
    for (int a = 0; a < 2; ++a)
#pragma unroll
        for (int b = 0; b < 2; ++b)
#pragma unroll
            for (int m = 0; m < 4; ++m)
#pragma unroll
                for (int n = 0; n < 2; ++n) acc[a][b][m][n] = (f32x4){0.f, 0.f, 0.f, 0.f};
    bf16x8 At[4][2], B0[2][2], B1[2][2];
    const char* cA = (const char*)g.A + (size_t)cur.pm * tstep + (size_t)cur.k0 * kstep; const char* cB = (const char*)g.Bt + (size_t)cur.pn * tstep + (size_t)cur.k0 * kstep;
    S.a_ready(cur);
    if constexpr (SP2) {
        PG8_STAGE(PG8_SB(0, 0), cB, voffB); PG8_STAGE(PG8_SB(0, 1), cB + hstep, voffB); PG8_STAGE(PG8_SA(0, 0), cA, voffA); PG8_STAGE(PG8_SA(0, 1), cA + hstep, voffA);
        if (wr == 1) PG8_BAR;
        PG8_WAIT_V(2); PG8_BAR;
        PG8_STAGE(PG8_SB(1, 0), cB + kstep, voffB); PG8_STAGE(PG8_SA(1, 0), cA + kstep, voffA); PG8_STAGE(PG8_SB(1, 1), cB + hstep + kstep, voffB);
        PG8_WAIT_V(6); PG8_BAR;
    } else {
        PG8_STAGE(PG8_SB(0, 0), cB, voffB); PG8_STAGE(PG8_SA(0, 0), cA, voffA); PG8_STAGE(PG8_SB(0, 1), cB + hstep, voffB); PG8_STAGE(PG8_SA(0, 1), cA + hstep, voffA);
        if (wr == 1) PG8_BAR;
        PG8_WAIT_V(4); PG8_BAR;
        PG8_STAGE(PG8_SB(1, 0), cB + kstep, voffB); PG8_STAGE(PG8_SA(1, 0), cA + kstep, voffA); PG8_STAGE(PG8_SB(1, 1), cB + hstep + kstep, voffB);
        PG8_WAIT_V(6); PG8_BAR;
    }
    for (;;) {
        const bool has_next = S.next(ui + 1, nxt);
        const char* nA = has_next ? (const char*)g.A + (size_t)nxt.pm * tstep + (size_t)nxt.k0 * kstep : cA; const char* nB = has_next ? (const char*)g.Bt + (size_t)nxt.pn * tstep + (size_t)nxt.k0 * kstep : cB;
        const int nt = cur.nt;
        for (int t = 0; t < nt; t += 2) {
            const bool last = (t == nt - 2);
            const char* a1 = cA + (size_t)(t + 1) * kstep;
            const char* a2 = last ? nA : cA + (size_t)(t + 2) * kstep; const char* b2 = last ? nB : cB + (size_t)(t + 2) * kstep;
            const char* a3 = a2 + kstep; const char* b3 = b2 + kstep;
            if (last && has_next) S.a_ready(nxt);
            if constexpr (SP2) {
            PG8_LDB(B0, 0, 0); PG8_LDB(B1, 0, 1); PG8_SCHED; PG8_LDA(At, 0, 0); PG8_STAGE(PG8_SA(1, 1), a1 + hstep, voffA);
            PG8_WAIT_V(8); PG8_WAIT_L(0); PG8_BAR; PG8_MMA(0, 0, At, B0); PG8_MMA(0, 1, At, B1); PG8_BAR; PG8_SCHED;
            PG8_LDA(At, 0, 1); PG8_STAGE(PG8_SB(0, 0), b2, voffB); PG8_STAGE(PG8_SB(0, 1), b2 + hstep, voffB); PG8_STAGE(PG8_SA(0, 0), a2, voffA);
            PG8_WAIT_V(8); PG8_WAIT_L(0); PG8_BAR; PG8_MMA(1, 0, At, B0); PG8_MMA(1, 1, At, B1); PG8_BAR; PG8_SCHED;
            PG8_LDB(B0, 1, 0); PG8_LDB(B1, 1, 1); PG8_SCHED; PG8_LDA(At, 1, 0); PG8_STAGE(PG8_SA(0, 1), a2 + hstep, voffA);
            PG8_WAIT_V(8); PG8_WAIT_L(0); PG8_BAR; PG8_MMA(0, 0, At, B0); PG8_MMA(0, 1, At, B1); PG8_BAR; PG8_SCHED;
            PG8_LDA(At, 1, 1); PG8_STAGE(PG8_SB(1, 0), b3, voffB); PG8_STAGE(PG8_SB(1, 1), b3 + hstep, voffB); PG8_STAGE(PG8_SA(1, 0), a3, voffA);
            PG8_WAIT_V(8); PG8_WAIT_L(0); PG8_BAR; PG8_MMA(1, 0, At, B0); PG8_MMA(1, 1, At, B1); PG8_BAR; PG8_SCHED;
            } else {
            PG8_LDB(B0, 0, 0); PG8_SCHED; PG8_LDA(At, 0, 0); PG8_STAGE(PG8_SA(1, 1), a1 + hstep, voffA);
            PG8_WAIT_L(8); PG8_BAR; PG8_WAIT_L(0); PG8_MMA(0, 0, At, B0); PG8_BAR; PG8_SCHED;
            PG8_LDB(B1, 0, 1); PG8_STAGE(PG8_SB(0, 0), b2, voffB);
            PG8_BAR; PG8_WAIT_L(0); PG8_MMA(0, 1, At, B1); PG8_BAR;
            PG8_LDA(At, 0, 1); PG8_STAGE(PG8_SA(0, 0), a2, voffA);
            PG8_BAR; PG8_WAIT_L(0); PG8_MMA(1, 0, At, B0); PG8_BAR; PG8_SCHED;
            PG8_STAGE(PG8_SB(0, 1), b2 + hstep, voffB);
            PG8_WAIT_V(6); PG8_BAR; PG8_MMA(1, 1, At, B1); PG8_BAR;
            PG8_LDB(B0, 1, 0); PG8_SCHED; PG8_LDA(At, 1, 0); PG8_STAGE(PG8_SA(0, 1), a2 + hstep, voffA);
            PG8_WAIT_L(8); PG8_BAR; PG8_WAIT_L(0); PG8_MMA(0, 0, At, B0); PG8_BAR; PG8_SCHED;
            PG8_LDB(B1, 1, 1); PG8_STAGE(PG8_SB(1, 0), b3, voffB);
            PG8_BAR; PG8_WAIT_L(0); PG8_MMA(0, 1, At, B1); PG8_BAR;
            PG8_LDA(At, 1, 1); PG8_STAGE(PG8_SA(1, 0), a3, voffA);
            PG8_BAR; PG8_WAIT_L(0); PG8_MMA(1, 0, At, B0); PG8_BAR; PG8_SCHED;
            PG8_STAGE(PG8_SB(1, 1), b3 + hstep, voffB);
            PG8_WAIT_V(6); PG8_BAR; PG8_MMA(1, 1, At, B1); PG8_BAR;
            }
        }
        if constexpr (ALIGN_EPI) { if (wr == 0) PG8_BAR; }
        if constexpr (!Epi::AFTER_DRAIN) { E(acc, cur, wr, wc, fr, fq); S.done(cur); }
        if (!has_next) break;
#pragma unroll
        for (int a = 0; a < 2; ++a)
#pragma unroll
            for (int b = 0; b < 2; ++b)
#pragma unroll
                for (int m = 0; m < 4; ++m)
#pragma unroll
                    for (int n = 0; n < 2; ++n) acc[a][b][m][n] = (f32x4){0.f, 0.f, 0.f, 0.f};
        cur = nxt; cA = nA; cB = nB; ++ui;
        if constexpr (ALIGN_EPI) { if (wr == 1) PG8_BAR; }
    }
    PG8_WAIT_V(0);
    if constexpr (!ALIGN_EPI) { if (wr == 0) PG8_BAR; }
    PG8_BAR;
    if constexpr (Epi::AFTER_DRAIN) { E.fused(acc, cur, wr, wc, fr, fq, lds, wid, lane); S.done(cur); }
#undef PG8_SA
#undef PG8_SB
#undef PG8_STAGE
#undef PG8_LDA
#undef PG8_LDB
#undef PG8_MMA
#undef PG8_WAIT_V
#undef PG8_WAIT_L
#undef PG8_BAR
#undef PG8_SCHED
}
}

struct Ctx {
    const Params* p; LAS unsigned char* lds; int tid, lane, wid, G, bid;
    _Float16* X; float* outp; float* mod; float* lb; bf16_t* H; unsigned char* big; unsigned char* oacc;
};

__device__ __forceinline__ void conv_w(const Ctx& c, const float* src, int ldsrc, int K, bf16_t* dst, int Ndst, int mode, int half, int item0, int& items_done) {
    LAS float* tile = (LAS float*)c.lds;
    const int nkt = K / 128, ntiles = (Ndst / 64) * nkt;
    for (int t = c.bid; t < ntiles; t += c.G) {
        const int nt = t / nkt, kt = t % nkt, nbase = nt * 64, kbase = kt * 128;
        {
            const int n4 = (c.tid & 15) * 4, kr = c.tid >> 4; const int nd = nbase + n4; int sc; float scale = 1.f; bool valid = true;
            if (mode == 1) { const int pn = nd >> 8, jj = nd & 255; sc = (jj < 128) ? pn * 128 + jj : half + pn * 128 + jj - 128; }
            else if (mode == 2) { sc = nd; valid = nd < 3104; if (nd < 512) scale = 0.08838834764831845f; }
            else sc = nd;
            f32x4 v[4];
#pragma unroll
            for (int ps = 0; ps < 4; ++ps) v[ps] = valid ? __builtin_nontemporal_load((const f32x4*)(src + (size_t)(kbase + kr + 32 * ps) * ldsrc + sc)) : (f32x4){0.f, 0.f, 0.f, 0.f};
#pragma unroll
            for (int ps = 0; ps < 4; ++ps) { LAS float* tp = tile + (kr + 32 * ps) * 65 + n4; tp[0] = v[ps][0] * scale; tp[1] = v[ps][1] * scale; tp[2] = v[ps][2] * scale; tp[3] = v[ps][3] * scale; }
        }
        __syncthreads();
        {
            const int n = c.tid >> 3, k16 = (c.tid & 7) * 16; unsigned w[8];
#pragma unroll
            for (int i = 0; i < 8; ++i) w[i] = cvt_pk_bf16(tile[(k16 + 2 * i) * 65 + n], tile[(k16 + 2 * i + 1) * 65 + n]);
            bf16_t* dp = dst + (size_t)(nbase + n) * K + kbase + k16;
            *(u32x4*)dp = (u32x4){w[0], w[1], w[2], w[3]}; *(u32x4*)(dp + 8) = (u32x4){w[4], w[5], w[6], w[7]};
        }
        __syncthreads();
    }
}
__device__ __forceinline__ void conv_ffn(const Ctx& c, int layer) {
    const float* wi = GIN(c.p->in[7]) + (size_t)layer * 2 * D * 2 * DFF; const float* wo = GIN(c.p->in[8]) + (size_t)layer * 2 * DFF * D; int dummy = 0;
    for (int s = 0; s < 2; ++s) {
        conv_w(c, wi + (size_t)s * D * 2 * DFF, 2 * DFF, D, (bf16_t*)((unsigned char*)(GAS1 unsigned char*)c.p->ws + WS_WFI) + (size_t)s * 2 * DFF * D, 2 * DFF, 1, DFF, 0, dummy);
        conv_w(c, wo + (size_t)s * DFF * D, D, DFF, (bf16_t*)((unsigned char*)(GAS1 unsigned char*)c.p->ws + WS_WFO) + (size_t)s * D * DFF, D, 0, 0, 0, dummy);
    }
}

__device__ __forceinline__ void phase_prep(const Ctx& c) {
    for (int e = c.bid * NTHR + c.tid; e < 2 * D; e += c.G * NTHR) {
        const float* lg = GIN(c.p->in[25]); float v[4], mx = -1e30f;
        for (int l = 0; l < 4; ++l) { v[l] = lg[(size_t)l * 2 * D + e]; mx = fmaxf(mx, v[l]); }
        float s = 0.f; for (int l = 0; l < 4; ++l) { v[l] = expf(v[l] - mx); s += v[l]; }
        c.lb[e] = (v[1] + v[2]) / s;
    }
    {
        LAS float* sc = (LAS float*)c.lds;
        LAS float* red = sc + 9 * 1024;
        for (int e = c.tid; e < 9 * 1024; e += NTHR) { const int r = e >> 10, k = e & 1023; const float v = r < 8 ? GIN(c.p->in[1])[r * D + k] : GIN(c.p->in[3])[k]; sc[e] = v / (1.0f + expf(-v)); }
        __syncthreads();
        for (int it = c.bid; it < 4 * 144; it += c.G) {
            const int l = it / 144, cg_ = it % 144, col = c.tid & 63, ks = c.tid >> 6;
            const float* w = GIN(c.p->in[4]) + (size_t)l * D * 9216 + (size_t)(ks * 128) * 9216 + cg_ * 64 + col;
            float a[9];
#pragma unroll
            for (int r = 0; r < 9; ++r) a[r] = 0.f;
            for (int k0 = 0; k0 < 128; k0 += 16) { float wv[16];
#pragma unroll
                for (int kk = 0; kk < 16; ++kk) wv[kk] = __builtin_nontemporal_load(w + (size_t)(k0 + kk) * 9216);
#pragma unroll
                for (int kk = 0; kk < 16; ++kk)
#pragma unroll
                    for (int r = 0; r < 9; ++r) a[r] += sc[r * 1024 + ks * 128 + k0 + kk] * wv[kk]; }
#pragma unroll
            for (int r = 0; r < 9; ++r) red[(ks * 9 + r) * 64 + col] = a[r];
            __syncthreads();
            for (int e = c.tid; e < 9 * 64; e += NTHR) { const int r = e >> 6, cc = e & 63; float s = GIN(c.p->in[5])[(size_t)l * 9216 + cg_ * 64 + cc];
                for (int q = 0; q < 8; ++q) s += red[(q * 9 + r) * 64 + cc];
                c.mod[((size_t)l * 9 + r) * 9216 + cg_ * 64 + cc] = s; }
            __syncthreads();
        }
    }
    int dummy = 0;
    for (int j = 0; j < 2; ++j) conv_w(c, GIN(c.p->in[17]) + (size_t)j * D * 2 * D, 2 * D, D, (bf16_t*)((unsigned char*)(GAS1 unsigned char*)c.p->ws + WS_WGLU) + (size_t)j * 2 * D * D, 2 * D, 1, D, 0, dummy);
    conv_w(c, GIN(c.p->in[19]), 3104, D, (bf16_t*)((unsigned char*)(GAS1 unsigned char*)c.p->ws + WS_WGI), 3328, 2, 0, 0, dummy);
    conv_w(c, GIN(c.p->in[23]), D, D, (bf16_t*)((unsigned char*)(GAS1 unsigned char*)c.p->ws + WS_WGO), D, 0, 0, 0, dummy);
    conv_w(c, GIN(c.p->in[24]), 5 * D, D, (bf16_t*)((unsigned char*)(GAS1 unsigned char*)c.p->ws + WS_WHI), 5 * D, 0, 0, 0, dummy);
    conv_w(c, GIN(c.p->in[27]), D, D, (bf16_t*)((unsigned char*)(GAS1 unsigned char*)c.p->ws + WS_WHO), D, 0, 0, 0, dummy);
    conv_ffn(c, 0);
}

__device__ __forceinline__ void phase_norm(const Ctx& c, int layer, int sub, bool from_input, bool permute, int nparts, int nrows, int row_lo) {
    const float* w = GIN(c.p->in[6]) + ((size_t)layer * 3 + sub) * D;
    const float* modl = c.mod + (size_t)layer * 9 * 9216;
    for (int row = row_lo + c.bid * 8 + c.wid; row < nrows; row += c.G * 8) {
        const int b = row < ML ? (row >> 12) : 8;
        _Float16* xr = c.X + (size_t)row * D;
        f32x4 v[4]; float ss = 0.f;
        if (from_input) { const float* src = row < ML ? GIN(c.p->in[0]) + (size_t)row * D : GIN(c.p->in[2]) + (size_t)(row - ML) * D;
#pragma unroll
            for (int j = 0; j < 4; ++j) { v[j] = __builtin_nontemporal_load((const f32x4*)(src + j * 256 + c.lane * 4)); st_h4(xr + j * 256 + c.lane * 4, v[j]); }
        } else {
#pragma unroll
            for (int j = 0; j < 4; ++j) { const u32x2 w = __builtin_nontemporal_load((const u32x2*)(xr + j * 256 + c.lane * 4)); v[j] = (f32x4){h2lo(w.x), h2hi(w.x), h2lo(w.y), h2hi(w.y)}; }
        }
        if (nparts > 0 && row >= ML) {
            const _Float16* pp = (const _Float16*)c.oacc + (size_t)(row - ML) * D;
            for (int s = 0; s < nparts; ++s)
#pragma unroll
                for (int j = 0; j < 4; ++j) { const u32x2 w = __builtin_nontemporal_load((const u32x2*)(pp + (size_t)s * MC * D + j * 256 + c.lane * 4)); v[j] += (f32x4){h2lo(w.x), h2hi(w.x), h2lo(w.y), h2hi(w.y)}; }
#pragma unroll
            for (int j = 0; j < 4; ++j) st_h4(xr + j * 256 + c.lane * 4, v[j]);
        }
#pragma unroll
        for (int j = 0; j < 4; ++j) ss += v[j][0] * v[j][0] + v[j][1] * v[j][1] + v[j][2] * v[j][2] + v[j][3] * v[j][3];
#pragma unroll
        for (int o = 32; o >= 1; o >>= 1) ss += shfl_xor_l(ss, o, c.lane);
        const float rstd = rsqrtf(ss * (1.0f / D) + 1e-6f);
        const float* sh = modl + (size_t)b * 9216 + (sub * 3) * 1024; const float* scl = sh + 1024;
        const int drow = (permute && row < ML) ? permrow(row) : row;
        bf16_t* hp = c.H + (size_t)drow * D;
#pragma unroll
        for (int j = 0; j < 4; ++j) { const int col = j * 256 + c.lane * 4;
            const f32x4 wv = *(const f32x4*)(w + col), sv = *(const f32x4*)(scl + col), hv = *(const f32x4*)(sh + col);
            f32x4 y = v[j] * rstd * wv * (sv + 1.0f) + hv;
            u32x2 o; o.x = cvt_pk_bf16(y[0], y[1]); o.y = cvt_pk_bf16(y[2], y[3]); *(u32x2*)(hp + col) = o; }
    }
}
__device__ __forceinline__ void phase_final(const Ctx& c) {
    const float* w = GIN(c.p->in[28]);
    for (int row = c.bid * 8 + c.wid; row < ML; row += c.G * 8) {
        const _Float16* xr = c.X + (size_t)row * D; float* op = c.outp + (size_t)row * D; f32x4 v[4]; float ss = 0.f;
#pragma unroll
        for (int j = 0; j < 4; ++j) { const u32x2 wv = __builtin_nontemporal_load((const u32x2*)(xr + j * 256 + c.lane * 4)); v[j] = (f32x4){h2lo(wv.x), h2hi(wv.x), h2lo(wv.y), h2hi(wv.y)}; ss += v[j][0] * v[j][0] + v[j][1] * v[j][1] + v[j][2] * v[j][2] + v[j][3] * v[j][3]; }
#pragma unroll
        for (int o = 32; o >= 1; o >>= 1) ss += shfl_xor_l(ss, o, c.lane);
        const float rstd = rsqrtf(ss * (1.0f / D) + 1e-6f);
#pragma unroll
        for (int j = 0; j < 4; ++j) { const int col = j * 256 + c.lane * 4; __builtin_nontemporal_store(v[j] * rstd * *(const f32x4*)(w + col), (f32x4*)(op + col)); }
    }
}

__device__ __forceinline__ int s5_row(int b, int dir, int ci, int t) {
    if (ci < 8) { const int s = ci * 32 + t; return ML + b * CTXL + (dir ? (CTXL - 1 - s) : s); }
    const int s = (ci - 8) * 32 + t; return b * SEQ + (dir ? (SEQ - 1 - s) : s);
}
__device__ __forceinline__ void phase_s5_scan(const Ctx& c, int j) {
    if (c.wid >= 4) return;
    constexpr int LDW = 132;
    LAS float* buf = (LAS float*)c.lds + c.wid * 32 * LDW;
    const int l = c.lane;
    bf16_t* Yf = (bf16_t*)c.big; bf16_t* Yb = Yf + (size_t)MT * D;
    for (int unit = c.bid * 4 + c.wid; unit < NB * 64 * 2; unit += c.G * 4) {
        const int dir = unit & 1, g = (unit >> 1) & 63, b = unit >> 7;
        const size_t gi = ((size_t)j * 2 + dir) * 64 + g;
        const float dt = expf(GIN(c.p->in[11])[gi]);
        bf16x8 Bop[4];
#pragma unroll
        for (int ph = 0; ph < 2; ++ph) {
            const int pp = ph * 32 + (l & 31);
            const float are = GIN(c.p->in[9])[gi * 64 + pp], aim = GIN(c.p->in[10])[gi * 64 + pp];
            const float mag = expf(are * dt), abr = mag * cosf(aim * dt), abi = mag * sinf(aim * dt), den = are * are + aim * aim;
            const float zr = abr - 1.0f, zi = abi, cre = (zr * are + zi * aim) / den, cim = (zi * are - zr * aim) / den;
            const float* bre = GIN(c.p->in[12]) + (gi * 64 + pp) * 16 + 8 * (l >> 5); const float* bim = GIN(c.p->in[13]) + (gi * 64 + pp) * 16 + 8 * (l >> 5);
#pragma unroll
            for (int e = 0; e < 8; ++e) { const float br = bre[e], bi = bim[e];
                Bop[ph][e] = (short)f2bf(cre * br - cim * bi); Bop[2 + ph][e] = (short)f2bf(cre * bi + cim * br); }
        }
        float ar, ai;
        { const float are = GIN(c.p->in[9])[gi * 64 + l], aim = GIN(c.p->in[10])[gi * 64 + l]; const float mag = expf(are * dt); ar = mag * cosf(aim * dt); ai = mag * sinf(aim * dt); }
        bf16x8 Cop[4];
#pragma unroll
        for (int ks = 0; ks < 4; ++ks) {
            const int p0 = 32 * ks + 8 * (l >> 4); const int cc = l & 15;
            const float* src = (p0 < 64) ? GIN(c.p->in[14]) + (gi * 16 + cc) * 64 + p0 : GIN(c.p->in[15]) + (gi * 16 + cc) * 64 + (p0 - 64);
            const float sg = (p0 < 64) ? 1.0f : -1.0f;
#pragma unroll
            for (int e = 0; e < 8; ++e) Cop[ks][e] = (short)f2bf(sg * src[e]);
        }
        GAS1 bf16_t* Y = (GAS1 bf16_t*)(dir ? Yb : Yf);
        const GAS1 bf16_t* Hg_ = (const GAS1 bf16_t*)c.H;
        float hr = 0.f, hi = 0.f;
        bf16x8 Aring[4];
#pragma unroll
        for (int q = 0; q < 4; ++q) Aring[q] = *(const GAS1 bf16x8*)(Hg_ + (size_t)s5_row(b, dir, q, l & 31) * D + g * 16 + 8 * (l >> 5));
        for (int ci0 = 0; ci0 < 136; ci0 += 4) {
#pragma unroll
          for (int cq = 0; cq < 4; ++cq) {
            const int ci = ci0 + cq;
            const bf16x8 A = Aring[cq];
            if (ci + 4 < 136) Aring[cq] = *(const GAS1 bf16x8*)(Hg_ + (size_t)s5_row(b, dir, ci + 4, l & 31) * D + g * 16 + 8 * (l >> 5));
#pragma unroll
            for (int nt = 0; nt < 4; ++nt) {
                f32x16 acc;
#pragma unroll
                for (int i = 0; i < 16; ++i) acc[i] = 0.f;
                acc = __builtin_amdgcn_mfma_f32_32x32x16_bf16(A, Bop[nt], acc, 0, 0, 0);
#pragma unroll
                for (int i = 0; i < 16; ++i) { const int t = (i & 3) + 8 * (i >> 2) + 4 * (l >> 5); buf[t * LDW + 32 * nt + (l & 31)] = acc[i]; }
            }
            __builtin_amdgcn_fence(__ATOMIC_RELEASE, "wavefront"); __builtin_amdgcn_wave_barrier();
            {
                float br[32], bi[32];
#pragma unroll
                for (int t = 0; t < 32; ++t) { br[t] = buf[t * LDW + l]; bi[t] = buf[t * LDW + 64 + l]; }
#pragma unroll
                for (int t = 0; t < 32; ++t) { const float nr = ar * hr - ai * hi + br[t], ni = ar * hi + ai * hr + bi[t]; hr = nr; hi = ni; br[t] = hr; bi[t] = hi; }
#pragma unroll
                for (int t = 0; t < 32; ++t) { buf[t * LDW + l] = br[t]; buf[t * LDW + 64 + l] = bi[t]; }
            }
            __builtin_amdgcn_fence(__ATOMIC_RELEASE, "wavefront"); __builtin_amdgcn_wave_barrier();
#pragma unroll
            for (int mt = 0; mt < 2; ++mt) {
                f32x4 acc = {0.f, 0.f, 0.f, 0.f};
#pragma unroll
                for (int ks = 0; ks < 4; ++ks) {
                    const LAS float* hp = buf + (16 * mt + (l & 15)) * LDW + 32 * ks + 8 * (l >> 4);
                    const f32x4 h0 = *(const LAS f32x4*)hp, h1 = *(const LAS f32x4*)(hp + 4);
                    union { u32x4 u; bf16x8 v; } cv; cv.u.x = cvt_pk_bf16(h0[0], h0[1]); cv.u.y = cvt_pk_bf16(h0[2], h0[3]); cv.u.z = cvt_pk_bf16(h1[0], h1[1]); cv.u.w = cvt_pk_bf16(h1[2], h1[3]);
                    acc = __builtin_amdgcn_mfma_f32_16x16x32_bf16(cv.v, Cop[ks], acc, 0, 0, 0);
                }
#pragma unroll
                for (int i = 0; i < 4; ++i) { const int t = 16 * mt + 4 * (l >> 4) + i; Y[(size_t)s5_row(b, dir, ci, t) * D + g * 16 + (l & 15)] = f2bf(acc[i]); }
            }
            __builtin_amdgcn_fence(__ATOMIC_RELEASE, "wavefront"); __builtin_amdgcn_wave_barrier();
          }
        }
    }
}
__device__ __forceinline__ void phase_s5_post(const Ctx& c, int j) {
    const bf16_t* Yf = (const bf16_t*)c.big; const bf16_t* Yb = Yf + (size_t)MT * D; bf16_t* Gb = (bf16_t*)c.oacc; const float* dsk = GIN(c.p->in[16]) + (size_t)j * D;
    const size_t n8 = (size_t)MT * D / 8;
    for (size_t e = (size_t)c.bid * NTHR + c.tid; e < n8; e += (size_t)c.G * NTHR) {
        const size_t off = e * 8; const int col = (int)(off & (D - 1));
        const u32x4 av = __builtin_nontemporal_load((const u32x4*)(Yf + off)), bv = __builtin_nontemporal_load((const u32x4*)(Yb + off));
        const f32x4 d0 = *(const f32x4*)(dsk + col), d1 = *(const f32x4*)(dsk + col + 4);
        const u32x4 hv = __builtin_nontemporal_load((const u32x4*)(c.H + off));
        float y[8];
        y[0] = bflo(av.x) + bflo(bv.x) + d0[0] * bflo(hv.x); y[1] = bfhi(av.x) + bfhi(bv.x) + d0[1] * bfhi(hv.x); y[2] = bflo(av.y) + bflo(bv.y) + d0[2] * bflo(hv.y); y[3] = bfhi(av.y) + bfhi(bv.y) + d0[3] * bfhi(hv.y);
        y[4] = bflo(av.z) + bflo(bv.z) + d1[0] * bflo(hv.z); y[5] = bfhi(av.z) + bfhi(bv.z) + d1[1] * bfhi(hv.z); y[6] = bflo(av.w) + bflo(bv.w) + d1[2] * bflo(hv.w); y[7] = bfhi(av.w) + bfhi(bv.w) + d1[3] * bfhi(hv.w);
#pragma unroll
        for (int i = 0; i < 8; ++i) { const float x = y[i]; const float t = 0.7978845608028654f * (x + 0.044715f * x * x * x); const float th = 1.0f - 2.0f * __builtin_amdgcn_rcpf(1.0f + __expf(2.0f * t)); y[i] = 0.5f * x * (1.0f + th); }
        u32x4 o; o.x = cvt_pk_bf16(y[0], y[1]); o.y = cvt_pk_bf16(y[2], y[3]); o.z = cvt_pk_bf16(y[4], y[5]); o.w = cvt_pk_bf16(y[6], y[7]);
        *(u32x4*)(Gb + off) = o;
    }
}

template <bool GLA>
__device__ __forceinline__ void phase_scan_pre(const Ctx& c) {
    if (GLA) {
        const bf16_t* P = (const bf16_t*)c.big; unsigned* Hg = (unsigned*)c.H;
        const int dir = c.tid >> 8, kp = c.tid & 255;
        float w0[16], w1[16];
#pragma unroll
        for (int r = 0; r < 16; ++r) { w0[r] = GIN(c.p->in[20])[((size_t)dir * 16 + r) * 512 + 2 * kp]; w1[r] = GIN(c.p->in[20])[((size_t)dir * 16 + r) * 512 + 2 * kp + 1]; }
        const float b0 = GIN(c.p->in[21])[dir * 512 + 2 * kp], b1 = GIN(c.p->in[21])[dir * 512 + 2 * kp + 1];
        for (int row = c.bid; row < MT; row += c.G) {
            const u32x4 l0 = *(const u32x4*)(P + (size_t)row * 3328 + 3072 + dir * 16), l1 = *(const u32x4*)(P + (size_t)row * 3328 + 3072 + dir * 16 + 8);
            const unsigned lw[8] = {l0.x, l0.y, l0.z, l0.w, l1.x, l1.y, l1.z, l1.w};
            float p0 = b0, p1 = b1;
#pragma unroll
            for (int r = 0; r < 8; ++r) { const float a = bflo(lw[r]), bb = bfhi(lw[r]); p0 += a * w0[2 * r] + bb * w0[2 * r + 1]; p1 += a * w1[2 * r] + bb * w1[2 * r + 1]; }
            const float g0 = -(fmaxf(-p0, 0.f) + __logf(1.0f + __expf(-fabsf(p0)))) * 0.0625f, g1 = -(fmaxf(-p1, 0.f) + __logf(1.0f + __expf(-fabsf(p1)))) * 0.0625f;
            Hg[(size_t)row * 512 + dir * 256 + kp] = pack_h2(g0, g1);
        }
    } else {
        unsigned* P = (unsigned*)c.big;
        const int cp = c.tid;
        const float lf0 = c.lb[2 * cp], lf1 = c.lb[2 * cp + 1], lb0 = c.lb[D + 2 * cp], lb1 = c.lb[D + 2 * cp + 1];
        for (int row = c.bid; row < MT; row += c.G) {
            unsigned* pr = P + (size_t)row * 2560;
            const unsigned qw = pr[cp], zf = pr[1024 + cp], zb = pr[1536 + cp];
            pr[cp] = cvt_pk_bf16(fsilu(bflo(qw)), fsilu(bfhi(qw)));
            { const float s0 = fsigmoid(fminf(fmaxf(bflo(zf), -30.f), 30.f)), s1 = fsigmoid(fminf(fmaxf(bfhi(zf), -30.f), 30.f));
              pr[1024 + cp] = pack_h2(__logf(lf0 + (1.0f - lf0) * s0), __logf(lf1 + (1.0f - lf1) * s1)); }
            { const float s0 = fsigmoid(fminf(fmaxf(bflo(zb), -30.f), 30.f)), s1 = fsigmoid(fminf(fmaxf(bfhi(zb), -30.f), 30.f));
              pr[1536 + cp] = pack_h2(__logf(lb0 + (1.0f - lb0) * s0), __logf(lb1 + (1.0f - lb1) * s1)); }
        }
    }
}
template <bool GLA>
__device__ __forceinline__ void phase_chunk_scan(const Ctx& c) {
    constexpr int NH = GLA ? 4 : 8, DV = GLA ? 256 : 128, NSL = DV / 64, LDP = GLA ? 3328 : 5120;
    constexpr int QS = 272, KTS = 144;
    constexpr int OFF_KS = 64 * QS, OFF_KT = 2 * 64 * QS, OFF_VT = OFF_KT + 128 * KTS, OFF_EL = OFF_VT + 64 * KTS, BUFSZ = OFF_EL + 512;
    LAS unsigned char* L = c.lds;
    LAS unsigned char* Ss = L + 2 * BUFSZ;
    LAS unsigned char* StT = Ss + 64 * KTS;
    LAS float* part = (LAS float*)(StT + 64 * QS);
    static_assert(2 * BUFSZ + 64 * KTS + 64 * QS + 4096 <= LDS_MAIN, "chunk scan LDS");
    const GAS1 bf16_t* P = (const GAS1 bf16_t*)c.big;
    const GAS1 unsigned* Hg = (const GAS1 unsigned*)c.H;
    GAS1 bf16_t* OF = (GAS1 bf16_t*)c.oacc; GAS1 bf16_t* OB = OF + (size_t)MT * D;
    const int tid = c.tid, l = c.lane, w = c.wid, kp = tid & 63, jg = tid >> 6;
    const int vcu = (c.G % 8 == 0) ? (c.bid % 8) * (c.G / 8) + c.bid / 8 : c.bid;
    for (int unit = vcu; unit < NB * NH * 2 * NSL; unit += c.G) {
        const int sl = unit % NSL, dir = (unit / NSL) & 1, h = (unit / (2 * NSL)) % NH, b = unit / (2 * NSL * NH);
        GAS1 bf16_t* Oout = dir ? OB : OF;
        const int qcol = h * 128 + 2 * kp;
        const int kcol = 512 + h * 128 + 2 * kp;
        const int vcol = (GLA ? 1024 + h * 256 : 1024 + h * 128) + sl * 64;
        f32x4 st[4];
#pragma unroll
        for (int vt = 0; vt < 4; ++vt) st[vt] = (f32x4){0.f, 0.f, 0.f, 0.f};
        for (int e = tid; e < 64 * QS / 4; e += NTHR) ((LAS unsigned*)StT)[e] = 0u;
        unsigned nq[8], nk[8], ng[8]; u32x4 nv;
        unsigned rq[8], rk[8], rg[8]; u32x4 rv;
        float c0[8], c1[8];
#define CS_CB(ci) ((ci) < 4 ? ML + b * CTXL + (dir ? 3 - (ci) : (ci)) * 64 : b * SEQ + (dir ? 63 - ((ci) - 4) : ((ci) - 4)) * 64)
#define CS_LOAD(ci) do { const int cb_ = CS_CB(ci); \
            _Pragma("unroll") for (int jj = 0; jj < 8; ++jj) { const int jp_ = jg * 8 + jj; const size_t row_ = (size_t)(cb_ + (dir ? 63 - jp_ : jp_)); \
                nq[jj] = *(const GAS1 unsigned*)(P + row_ * LDP + qcol); \
                if (GLA) { nk[jj] = *(const GAS1 unsigned*)(P + row_ * LDP + kcol); ng[jj] = Hg[row_ * 512 + dir * 256 + h * 64 + kp]; } \
                else { ng[jj] = *(const GAS1 unsigned*)(P + row_ * LDP + (2 + dir) * 1024 + qcol); nk[jj] = 0u; } } \
            { const int jp_ = tid & 63, v8_ = tid >> 6; const size_t row_ = (size_t)(cb_ + (dir ? 63 - jp_ : jp_)); nv = *(const GAS1 u32x4*)(P + row_ * LDP + vcol + v8_ * 8); } } while (0)
#define CS_EW1(ci_next) do { rv = nv; \
            _Pragma("unroll") for (int jj = 0; jj < 8; ++jj) { rq[jj] = nq[jj]; rk[jj] = nk[jj]; rg[jj] = ng[jj]; } \
            if ((ci_next) < 68) CS_LOAD(ci_next); \
            float run0 = 0.f, run1 = 0.f; \
            _Pragma("unroll") for (int jj = 0; jj < 8; ++jj) { run0 += h2lo(rg[jj]); run1 += h2hi(rg[jj]); c0[jj] = run0; c1[jj] = run1; } \
            *(LAS f32v2_t*)(part + jg * 128 + 2 * kp) = (f32v2_t){run0, run1}; } while (0)
#define CS_EW2(B) do { LAS unsigned char* Qs_ = (B); LAS unsigned char* Ks_ = (B) + OFF_KS; LAS unsigned char* KT_ = (B) + OFF_KT; LAS unsigned char* VT_ = (B) + OFF_VT; LAS float* el_ = (LAS float*)((B) + OFF_EL); \
            float off0 = 0.f, off1 = 0.f, tot0 = 0.f, tot1 = 0.f; \
            _Pragma("unroll") for (int q = 0; q < 8; ++q) { const f32v2_t pv = *(const LAS f32v2_t*)(part + q * 128 + 2 * kp); tot0 += pv.x; tot1 += pv.y; if (q < jg) { off0 += pv.x; off1 += pv.y; } } \
            if (jg == 0) *(LAS f32v2_t*)(el_ + 2 * kp) = (f32v2_t){__expf(tot0), __expf(tot1)}; \
            float ka[8], kb[8]; \
            _Pragma("unroll") for (int jj = 0; jj < 8; ++jj) { \
                const float cu0 = off0 + c0[jj], cu1 = off1 + c1[jj]; \
                const float e0 = __expf(cu0), e1 = __expf(cu1), i0 = __expf(-cu0), i1 = __expf(-cu1); \
                float kk0, kk1; \
                if (GLA) { kk0 = bflo(rk[jj]); kk1 = bfhi(rk[jj]); } else { kk0 = 1.0f - __expf(h2lo(rg[jj])); kk1 = 1.0f - __expf(h2hi(rg[jj])); } \
                const float q0 = bflo(rq[jj]) * e0, q1 = bfhi(rq[jj]) * e1; \
                ka[jj] = kk0 * i0; kb[jj] = kk1 * i1; \
                const int jp = jg * 8 + jj; \
                *(LAS unsigned*)(Qs_ + jp * QS + kp * 4) = cvt_pk_bf16(q0, q1); \
                *(LAS unsigned*)(Ks_ + jp * QS + kp * 4) = cvt_pk_bf16(ka[jj], kb[jj]); } \
            *(LAS u32x4*)(KT_ + (2 * kp) * KTS + jg * 16) = (u32x4){cvt_pk_bf16(ka[0], ka[1]), cvt_pk_bf16(ka[2], ka[3]), cvt_pk_bf16(ka[4], ka[5]), cvt_pk_bf16(ka[6], ka[7])}; \
            *(LAS u32x4*)(KT_ + (2 * kp + 1) * KTS + jg * 16) = (u32x4){cvt_pk_bf16(kb[0], kb[1]), cvt_pk_bf16(kb[2], kb[3]), cvt_pk_bf16(kb[4], kb[5]), cvt_pk_bf16(kb[6], kb[7])}; \
            { const int jp = tid & 63, v8 = tid >> 6; const unsigned vw[4] = {rv.x, rv.y, rv.z, rv.w}; \
              _Pragma("unroll") for (int e = 0; e < 4; ++e) { *(LAS bf16_t*)(VT_ + (v8 * 8 + 2 * e) * KTS + jp * 2) = (bf16_t)(vw[e] & 0xffffu); *(LAS bf16_t*)(VT_ + (v8 * 8 + 2 * e + 1) * KTS + jp * 2) = (bf16_t)(vw[e] >> 16); } } } while (0)
        CS_LOAD(0);
        CS_EW1(1);
        __syncthreads();
        CS_EW2(L);
        __syncthreads();
        for (int ci = 0; ci < 68; ++ci) {
            const int cb = CS_CB(ci);
            LAS unsigned char* Bc = L + (ci & 1) * BUFSZ; LAS unsigned char* Bn = L + ((ci + 1) & 1) * BUFSZ;
            LAS unsigned char* Qs = Bc; LAS unsigned char* Ks = Bc + OFF_KS; LAS unsigned char* KT = Bc + OFF_KT; LAS unsigned char* VT = Bc + OFF_VT; LAS float* elast = (LAS float*)(Bc + OFF_EL);
            f32x4 oacc[2];
            if (w >= 4 && ci + 1 < 68) CS_EW1(ci + 2);
            {
                const int itS = w & 3, vtO = w & 3;
                bf16x8 qf[4], sf[4];
#pragma unroll
                for (int ks = 0; ks < 4; ++ks) { qf[ks] = *(const LAS bf16x8*)(Qs + (itS * 16 + (l & 15)) * QS + (ks * 32 + 8 * (l >> 4)) * 2); sf[ks] = *(const LAS bf16x8*)(StT + (vtO * 16 + (l & 15)) * QS + (ks * 32 + 8 * (l >> 4)) * 2); }
#pragma unroll
                for (int tt2 = 0; tt2 < 2; ++tt2) {
                    const int jt = (w >> 2) + 2 * tt2;
                    f32x4 s = {0.f, 0.f, 0.f, 0.f}, o = {0.f, 0.f, 0.f, 0.f};
                    if (jt <= itS) {
#pragma unroll
                        for (int ks = 0; ks < 4; ++ks) { const bf16x8 kf = *(const LAS bf16x8*)(Ks + (jt * 16 + (l & 15)) * QS + (ks * 32 + 8 * (l >> 4)) * 2); s = __builtin_amdgcn_mfma_f32_16x16x32_bf16(kf, qf[ks], s, 0, 0, 0); }
                    }
#pragma unroll
                    for (int ks = 0; ks < 4; ++ks) { const bf16x8 qo = *(const LAS bf16x8*)(Qs + (jt * 16 + (l & 15)) * QS + (ks * 32 + 8 * (l >> 4)) * 2); o = __builtin_amdgcn_mfma_f32_16x16x32_bf16(qo, sf[ks], o, 0, 0, 0); }
                    oacc[tt2] = o;
                    const int i = itS * 16 + (l & 15), j0 = jt * 16 + 4 * (l >> 4);
                    float sv[4];
#pragma unroll
                    for (int r = 0; r < 4; ++r) sv[r] = (j0 + r <= i) ? s[r] : 0.f;
                    *(LAS u32x2*)(Ss + i * KTS + j0 * 2) = (u32x2){cvt_pk_bf16(sv[0], sv[1]), cvt_pk_bf16(sv[2], sv[3])};
                }
            }
            if (w < 4 && ci + 1 < 68) CS_EW1(ci + 2);
            __syncthreads();
            if (w >= 4 && ci + 1 < 68) CS_EW2(Bn);
            {
                bf16x8 af[2];
#pragma unroll
                for (int ks = 0; ks < 2; ++ks) af[ks] = *(const LAS bf16x8*)(KT + (16 * w + (l & 15)) * KTS + (ks * 32 + 8 * (l >> 4)) * 2);
                f32x4 el;
#pragma unroll
                for (int r = 0; r < 4; ++r) el[r] = elast[16 * w + 4 * (l >> 4) + r];
#pragma unroll
                for (int tt2 = 0; tt2 < 2; ++tt2) {
                    const int it = (w >> 2) + 2 * tt2, vt = w & 3;
                    f32x4 o = oacc[tt2];
#pragma unroll
                    for (int ks = 0; ks < 2; ++ks) {
                        const bf16x8 a = *(const LAS bf16x8*)(Ss + (it * 16 + (l & 15)) * KTS + (ks * 32 + 8 * (l >> 4)) * 2);
                        const bf16x8 bv = *(const LAS bf16x8*)(VT + (vt * 16 + (l & 15)) * KTS + (ks * 32 + 8 * (l >> 4)) * 2);
                        o = __builtin_amdgcn_mfma_f32_16x16x32_bf16(a, bv, o, 0, 0, 0);
                    }
#pragma unroll
                    for (int r = 0; r < 4; ++r) { const int ip = it * 16 + 4 * (l >> 4) + r; const int row = cb + (dir ? 63 - ip : ip);
                        Oout[(size_t)row * D + h * DV + sl * 64 + vt * 16 + (l & 15)] = f2bf(o[r]); }
                }
#pragma unroll
                for (int vt = 0; vt < 4; ++vt) {
                    f32x4 s = st[vt];
#pragma unroll
                    for (int ks = 0; ks < 2; ++ks) { const bf16x8 bv = *(const LAS bf16x8*)(VT + (vt * 16 + (l & 15)) * KTS + (ks * 32 + 8 * (l >> 4)) * 2); s = __builtin_amdgcn_mfma_f32_16x16x32_bf16(af[ks], bv, s, 0, 0, 0); }
                    s = s * el; st[vt] = s;
                    *(LAS u32x2*)(StT + (vt * 16 + (l & 15)) * QS + (16 * w + 4 * (l >> 4)) * 2) = (u32x2){cvt_pk_bf16(s[0], s[1]), cvt_pk_bf16(s[2], s[3])};
                }
            }
            if (w < 4 && ci + 1 < 68) CS_EW2(Bn);
            __syncthreads();
        }
#undef CS_CB
#undef CS_LOAD
#undef CS_EW1
#undef CS_EW2
    }
}
template <bool GLA>
__device__ __forceinline__ void phase_scan_post(const Ctx& c) {
    constexpr int DV = GLA ? 256 : 128, LDP = GLA ? 3328 : 5120, GOFF = GLA ? 2048 : 4096;
    const bf16_t* P = (const bf16_t*)c.big; const bf16_t* OF = (const bf16_t*)c.oacc; const bf16_t* OB = OF + (size_t)MT * D;
    const float* nw = GLA ? GIN(c.p->in[22]) : GIN(c.p->in[26]);
    const int l = c.lane, col0 = l * 16;
    float wv[16];
#pragma unroll
    for (int i = 0; i < 16; ++i) wv[i] = nw[(col0 + i) & (DV - 1)];
    for (int row = c.bid * 8 + c.wid; row < MT; row += c.G * 8) {
        const u32x4 f0 = __builtin_nontemporal_load((const u32x4*)(OF + (size_t)row * D + col0)), f1 = __builtin_nontemporal_load((const u32x4*)(OF + (size_t)row * D + col0 + 8));
        const u32x4 b0 = __builtin_nontemporal_load((const u32x4*)(OB + (size_t)row * D + col0)), b1 = __builtin_nontemporal_load((const u32x4*)(OB + (size_t)row * D + col0 + 8));
        const u32x4 g0 = __builtin_nontemporal_load((const u32x4*)(P + (size_t)row * LDP + GOFF + col0)), g1 = __builtin_nontemporal_load((const u32x4*)(P + (size_t)row * LDP + GOFF + col0 + 8));
        const unsigned fw[8] = {f0.x, f0.y, f0.z, f0.w, f1.x, f1.y, f1.z, f1.w}, bw[8] = {b0.x, b0.y, b0.z, b0.w, b1.x, b1.y, b1.z, b1.w}, gw[8] = {g0.x, g0.y, g0.z, g0.w, g1.x, g1.y, g1.z, g1.w};
        float o[16]; float ss = 0.f;
#pragma unroll
        for (int i = 0; i < 8; ++i) { o[2 * i] = bflo(fw[i]) + bflo(bw[i]); o[2 * i + 1] = bfhi(fw[i]) + bfhi(bw[i]); ss += o[2 * i] * o[2 * i] + o[2 * i + 1] * o[2 * i + 1]; }
#pragma unroll
        for (int off = 1; off < DV / 16; off <<= 1) ss += shfl_xor_l(ss, off, l);
        const float rstd = rsqrtf(ss * (1.0f / DV) + 1e-6f);
        unsigned ow[8];
#pragma unroll
        for (int i = 0; i < 8; ++i) { const float y0 = o[2 * i] * rstd * wv[2 * i] * fsilu(bflo(gw[i])), y1 = o[2 * i + 1] * rstd * wv[2 * i + 1] * fsilu(bfhi(gw[i])); ow[i] = cvt_pk_bf16(y0, y1); }
        *(u32x4*)(c.H + (size_t)row * D + col0) = (u32x4){ow[0], ow[1], ow[2], ow[3]};
        *(u32x4*)(c.H + (size_t)row * D + col0 + 8) = (u32x4){ow[4], ow[5], ow[6], ow[7]};
    }
}

constexpr int NSTEP = 12;
constexpr int N_PHASES = 2 + DEPTH * NSTEP;
__device__ __forceinline__ bool phase_valid(int P) {
    if (P == 0 || P == N_PHASES - 1) return true;
    const int layer = (P - 1) / NSTEP, s = (P - 1) % NSTEP, kind = layer % 3;
    if ((s == 7 || s == 8) && kind == 0) return false;
    if (s == 5 && kind == 2) return false;
    return true;
}
#ifndef ENMASK
#define ENMASK 0xffff
#endif
#define EN(bit, stmt) do { if ((ENMASK >> (bit)) & 1) { stmt; } } while (0)
#ifndef FUSE_NORM
#define FUSE_NORM 0
#endif
#ifndef GEMM_ALIGN
#define GEMM_ALIGN true
#endif
#ifndef GEMM_SP2
#define GEMM_SP2 true
#endif
#ifndef DUPMASK
#define DUPMASK 0
#endif
#ifndef DIAG
#define DIAG 0
#endif
#ifndef PLIMIT
#define PLIMIT 1000
#endif
__device__ __forceinline__ bool phase_dup(int P) {
    if (DUPMASK == 0 || P == N_PHASES - 1) return false;
    if (P == 0) return (DUPMASK >> 11) & 1;
    const int layer = (P - 1) / NSTEP, s = (P - 1) % NSTEP, kind = layer % 3; int bit = -1;
    if (s == 0 && layer > 0) bit = 12; else if (s == 2 || s == 11) bit = 8; else if (s == 8) bit = 10; else if (s == 1 || s == 10) bit = 1; else if (s == 3 || s == 9) bit = 2; else if (s == 4) bit = kind == 0 ? 3 : 6; else if (s == 5) bit = kind == 0 ? 7 : -1; else if (s == 6 && kind != 0) bit = (kind == 1 ? 4 : 5); else if (s == 7 && kind != 0) bit = 7;
    return bit >= 0 && ((DUPMASK >> bit) & 1);
}
enum { G_NONE = 0, G_SWIGLU, G_RESID, G_PLAIN, G_GLU };

__global__ void __launch_bounds__(NTHR, 2) fwd_kernel(Params prm) {
    extern __shared__ __attribute__((aligned(16))) unsigned char lds_raw[];
#if COOP
    { LAS unsigned* stz = (LAS unsigned*)((LAS unsigned char*)lds_raw + LDS_MAIN); if (threadIdx.x < 4) stz[threadIdx.x] = 0u; }
    __syncthreads();
    bool first_seam = true;
    XcdBarrier xbar = xcd_barrier_post((unsigned*)(prm.ws + WS_BAR), (volatile LAS unsigned*)((LAS unsigned char*)lds_raw + LDS_MAIN));
#endif
    for (int Pi = prm.ph_lo * 2; Pi < prm.ph_hi * 2; ++Pi) {
        const int P = Pi >> 1;
        if ((Pi & 1) && !phase_dup(P)) continue;
        if (!phase_valid(P)) continue;
        if (P >= PLIMIT && P != N_PHASES - 1) continue;
        Ctx c;
        { int tid = threadIdx.x; asm volatile("" : "+v"(tid)); unsigned char* ws = prm.ws; asm volatile("" : "+s"(ws)); float* outp = prm.out; asm volatile("" : "+s"(outp));
          ws = (unsigned char*)(GAS1 unsigned char*)ws; outp = (float*)(GAS1 float*)outp;
          c.p = &prm; c.lds = (LAS unsigned char*)lds_raw; c.tid = tid; c.lane = tid & 63; c.wid = __builtin_amdgcn_readfirstlane(tid >> 6); { int gg = gridDim.x, bb = blockIdx.x; asm volatile("" : "+s"(gg), "+s"(bb)); c.G = gg; c.bid = bb; }
          c.X = (_Float16*)(ws + WS_X16); c.outp = outp; c.mod = (float*)(ws + WS_MOD); c.lb = (float*)(ws + WS_LB); c.H = (bf16_t*)(ws + WS_H); c.big = ws + WS_BIG; c.oacc = ws + WS_OACC; }
        unsigned char* const wsb = c.big - WS_BIG;
        bf16_t* const WFI = (bf16_t*)(wsb + WS_WFI); bf16_t* const WFO = (bf16_t*)(wsb + WS_WFO);
        int gt = G_NONE; const bf16_t* gA = nullptr; const bf16_t* gB = nullptr; int gN = 0, gK = 0, gM = MT;
        bf16_t* eO = nullptr; int eld = 0, emode = 0; int fz = 0, fseam = 0, fhperm = 0, fnl = 0, fns = 0; const float* emod = nullptr; float ecoef = 1.f; int eperm = 0, eskip = 0; const float* ebias = nullptr;
        if (P == 0) { EN(0, phase_prep(c)); }
        else if (P == N_PHASES - 1) {
#if DIAG == 0
            EN(1, phase_final(c));
#elif DIAG == 1
            { const bf16_t* OF = (const bf16_t*)c.oacc; const bf16_t* OB = OF + (size_t)MT * D; for (size_t e = (size_t)c.bid * NTHR + c.tid; e < (size_t)ML * D; e += (size_t)c.G * NTHR) prm.out[e] = bf2f(OF[e]) + bf2f(OB[e]); }
#elif DIAG == 2
            { const bf16_t* Pp = (const bf16_t*)c.big; for (size_t e = (size_t)c.bid * NTHR + c.tid; e < (size_t)ML * D; e += (size_t)c.G * NTHR) prm.out[e] = bf2f(Pp[(e >> 10) * 3328 + (e & 1023)]); }
#elif DIAG == 3
            { for (size_t e = (size_t)c.bid * NTHR + c.tid; e < (size_t)ML * D; e += (size_t)c.G * NTHR) prm.out[e] = bf2f(c.H[e]); }
#endif
        }
        else {
            const int layer = (P - 1) / NSTEP, s = (P - 1) % NSTEP, kind = layer % 3, j = layer / 3; const bool last = layer == DEPTH - 1;
            const float* modl = c.mod + (size_t)layer * 9 * 9216;
            switch (s) {
            case 0: EN(2, phase_norm(c, layer, 0, layer == 0, false, (layer > 0 && c.G == 256) ? 7 : 0, MT, (FUSE_NORM && c.G == 256 && layer > 0) ? ML : 0)); if (layer > 0) { EN(3, conv_ffn(c, layer)); } break;
            case 1: case 10: { const int sub = s == 1 ? 0 : 1; if (last && sub) gM = ML; gt = G_SWIGLU; gA = c.H; gB = WFI + (size_t)sub * 2 * DFF * D; gN = 2 * DFF; gK = D; eO = (bf16_t*)c.big; eld = DFF; } break;
            case 2: case 11: { const int sub = s == 2 ? 0 : 1; gt = G_RESID; gA = (const bf16_t*)c.big; gB = WFO + (size_t)sub * D * DFF; gN = D; gK = DFF; emod = modl + (sub ? 8 : 2) * 1024; ecoef = 0.5f; eskip = (last && sub) ? 1 : 0;
                if (FUSE_NORM && c.G == 256) { if (!sub) { fz = 1; fseam = layer * 3; fnl = layer; fns = 1; fhperm = kind == 1; }
                    else if (!last) { fz = 1; fseam = layer * 3 + 2; fnl = layer + 1; fns = 0; } } } break;
            case 3: EN(2, phase_norm(c, layer, 1, false, kind == 1, c.G == 256 ? 7 : 0, MT, (FUSE_NORM && c.G == 256) ? ML : 0)); break;
            case 4:
                if (kind == 0) { EN(4, phase_s5_scan(c, j)); }
                else if (kind == 1) { gt = G_PLAIN; gA = c.H; gB = (const bf16_t*)(wsb + WS_WGI); gN = 3328; gK = D; eO = (bf16_t*)c.big; eld = 3328; }
                else { gt = G_PLAIN; gA = c.H; gB = (const bf16_t*)(wsb + WS_WHI); gN = 5120; gK = D; eO = (bf16_t*)c.big; eld = 5120; emode = 1; }
                break;
            case 5:
                if (kind == 0) { EN(5, phase_s5_post(c, j)); } else if (kind == 1) { EN(8, phase_scan_pre<true>(c)); }
                break;
            case 6:
                if (kind == 0) { if (last) gM = ML; gt = G_GLU; gA = (const bf16_t*)c.oacc; gB = (const bf16_t*)(wsb + WS_WGLU) + (size_t)j * 2 * D * D; gN = 2 * D; gK = D; emod = modl + 5 * 1024; ebias = GIN(prm.in[18]) + (size_t)j * 2 * D; eskip = last ? 1 : 0; }
                else if (kind == 1) { EN(6, phase_chunk_scan<true>(c)); } else { EN(7, phase_chunk_scan<false>(c)); }
                break;
            case 7:
                if (kind == 1) { EN(8, phase_scan_post<true>(c)); } else { EN(8, phase_scan_post<false>(c)); }
                break;
            case 8: { gt = G_RESID; gA = c.H; gB = (const bf16_t*)(wsb + (kind == 1 ? WS_WGO : WS_WHO)); gN = D; gK = D; emod = modl + 5 * 1024; ecoef = 1.0f; eperm = kind == 1; eskip = last ? 1 : 0;
                if (FUSE_NORM && c.G == 256 && kind == 2) { fz = 1; fseam = layer * 3 + 1; fnl = layer; fns = 2; } } break;
            case 9: EN(2, phase_norm(c, layer, 2, false, false, (kind == 0 || c.G != 256) ? 0 : 4, last ? ML : MT, (FUSE_NORM && c.G == 256 && kind == 2) ? ML : 0)); break;
            }
        }
        if (gt != G_NONE) {
            pg8::Gemm g{gA, gB, gM, gN, gK}; pg8::StaticOrder S; S.init(gM, gN, c.G, c.bid, gK / 64);
            if (Pi & 1) ecoef = 0.f;
            if (gt == G_SWIGLU) { pg8::EpiSwiGLU E{eO, eld}; EN(9, (pg8::gemm_phase<pg8::EpiSwiGLU, pg8::StaticOrder, GEMM_ALIGN, GEMM_SP2>(c.lds, g, S, E))); }
            else if (gt == G_RESID) { pg8::SplitOrder SS; SS.init(ML, MT, gN, c.G, c.bid, gK / 64, gK == DFF ? 7 : 4, eskip); pg8::EpiResid E{c.X, wsb, emod, ecoef, eperm, eskip}; EN(10, (pg8::gemm_phase<pg8::EpiResid, pg8::SplitOrder, GEMM_ALIGN, GEMM_SP2>(c.lds, g, SS, E))); }
            else if (gt == G_PLAIN) { pg8::EpiPlain E{eO, eld, emode, c.lb}; EN(11, (pg8::gemm_phase<pg8::EpiPlain, pg8::StaticOrder, GEMM_ALIGN, GEMM_SP2>(c.lds, g, S, E))); }
            else { pg8::EpiGLU E{c.X, emod, ebias, eskip}; EN(12, (pg8::gemm_phase<pg8::EpiGLU, pg8::StaticOrder, GEMM_ALIGN, GEMM_SP2>(c.lds, g, S, E))); }
        }
        if (Pi + 1 < prm.ph_hi * 2) {
#if COOP
            if (first_seam) { cg::this_grid().sync(); first_seam = false; }
            else xcd_barrier(xbar);
            if (DUPMASK & 1) xcd_barrier(xbar);
#endif
        }
    }
}

extern "C" void kernel_launch(void* const* d_in, const int* in_sizes, int n_in, void* d_out, int out_size, void* d_ws, size_t ws_size, hipStream_t stream) {
    static int grid = 0;
    if (grid == 0) {
        if (n_in != 29 || ws_size < WS_END) { fprintf(stderr, "kernel_launch: need 29 inputs and %zu bytes of workspace; got %d, %zu\n", (size_t)WS_END, n_in, ws_size); grid = -1; return; }
        int dev = 0, cus = 0, per_cu = 0;
        hipGetDevice(&dev); hipDeviceGetAttribute(&cus, hipDeviceAttributeMultiprocessorCount, dev);
        if (hipFuncSetAttribute((const void*)fwd_kernel, hipFuncAttributeMaxDynamicSharedMemorySize, LDS_BYTES) != hipSuccess) { fprintf(stderr, "kernel_launch: hipFuncSetAttribute failed\n"); grid = -1; return; }
        if (hipOccupancyMaxActiveBlocksPerMultiprocessor(&per_cu, (const void*)fwd_kernel, NTHR, LDS_BYTES) != hipSuccess || per_cu < 1) { fprintf(stderr, "kernel_launch: occupancy query says %d\n", per_cu); per_cu = 1; }
        (void)hipGetLastError();
        grid = cus;
    }
    if (grid < 0) return;
    Params p{};
#if COOP
    if (hipMemsetAsync((char*)d_ws + WS_BAR, 0, WS_ZERO_BYTES, stream) != hipSuccess) { fprintf(stderr, "kernel_launch: memset of the barrier words failed\n"); return; }
#endif
    for (int i = 0; i < 29; ++i) p.in[i] = (const float*)d_in[i];
    p.out = (float*)d_out; p.ws = (unsigned char*)d_ws;
#if COOP
    p.ph_lo = 0; p.ph_hi = N_PHASES;
    void* args[] = {&p};
    hipError_t e = hipLaunchCooperativeKernel((const void*)fwd_kernel, dim3(grid), dim3(NTHR), args, LDS_BYTES, stream);
    if (e != hipSuccess) fprintf(stderr, "cooperative launch failed: %s (grid %d)\n", hipGetErrorString(e), grid);
#else
    for (int P = 0; P < N_PHASES; ++P) {
        const int layer = (P - 1) / NSTEP, s = (P - 1) % NSTEP;
        if (P != 0 && P != N_PHASES - 1 && (((s == 7 || s == 8) && layer % 3 == 0) || (s == 5 && layer % 3 == 2))) continue;
        if (P >= PLIMIT && P != N_PHASES - 1) continue;
        p.ph_lo = P; p.ph_hi = P + 1;
        hipLaunchKernelGGL(fwd_kernel, dim3(grid), dim3(NTHR), LDS_BYTES, stream, p);
    }
#endif
}
```
